# Optimizing an MI355X kernel written in HIP

```python
import math
import jax, jax.numpy as jnp
from jax import lax
import numpy as np

D_MODEL = 1024
BATCH = 4
SEQ = 4096
DEPTH = 4

CHUNK = 64
N_META = 16
META_PAD = CHUNK - N_META

A_HEADS = 6
A_DK = 64
A_DV = 64
A_WIDTH = A_HEADS * A_DV

B_HEADS = 6
B_HEADDIM = 64
B_WIDTH = B_HEADS * B_HEADDIM
B_GROUPS = 2
B_DSTATE = 128
B_CONV = 4
B_CONV_DIM = B_WIDTH + 2 * B_GROUPS * B_DSTATE

C_GROUPS = 16
C_GROUP_CH = 16
C_WIDTH = C_GROUPS * C_GROUP_CH
C_STATE = 64

D_MIX = A_WIDTH + B_WIDTH + C_WIDTH
D_FF = 4 * D_MODEL
SPLITS = (A_WIDTH, A_WIDTH, A_WIDTH, A_WIDTH, B_WIDTH, B_CONV_DIM, B_HEADS, C_WIDTH)
D_IN = sum(SPLITS)
ALPHA = (2 * DEPTH) ** 0.25
BETA = (8 * DEPTH) ** -0.25
LN_EPS = 1e-5
RMS_EPS = 1e-6
S5_MAX_RE = -1e-4

kernel_name = 'hybrid_hgrn2_ssd_s5_deepnorm'


def layer_norm(x, g, b):
    xf = x.astype(jnp.float32)
    mu = jnp.mean(xf, axis=-1, keepdims=True)
    var = jnp.mean(jnp.square(xf - mu), axis=-1, keepdims=True)
    y = (xf - mu) * lax.rsqrt(var + LN_EPS) * g.astype(jnp.float32) + b.astype(jnp.float32)
    return y.astype(x.dtype)


def rms_norm(x):
    xf = x.astype(jnp.float32)
    return xf * lax.rsqrt(jnp.mean(jnp.square(xf), axis=-1, keepdims=True) + RMS_EPS)


def pad_front(t):
    pad = [(0, 0)] * t.ndim
    pad[1] = (META_PAD, 0)
    return jnp.pad(t, pad)


def hgrn2_mixer(q_raw, f_raw, i_raw, g_raw, lb, norm_w):
    f32 = jnp.float32
    bsz, seq_len, _ = q_raw.shape
    zf = f_raw.astype(f32)
    q = jax.nn.silu(q_raw.astype(f32))
    log_f = jnp.logaddexp(jax.nn.log_sigmoid(zf), jnp.log(lb) + jax.nn.log_sigmoid(-zf))
    k = (1.0 - lb) * jax.nn.sigmoid(-zf)
    v = i_raw.astype(f32)

    def to_chunks(t, d):
        t = pad_front(t).reshape(bsz, -1, CHUNK, A_HEADS, d)
        return t.transpose(1, 0, 3, 2, 4)

    causal = jnp.tril(jnp.ones((CHUNK, CHUNK), dtype=bool))

    def chunk_step(state, inp):
        qc, kc, vc, gc = inp
        G = jnp.cumsum(gc, axis=2)
        o_inter = jnp.einsum('bhtk,bhkv->bhtv', qc * jnp.exp(G), state)
        diff = G[:, :, :, None, :] - G[:, :, None, :, :]
        decay = jnp.exp(jnp.where(causal[:, :, None], diff, -jnp.inf))
        scores = jnp.einsum('bhtsk,bhsk->bhts', qc[:, :, :, None, :] * decay, kc)
        o_intra = jnp.einsum('bhts,bhsv->bhtv', scores, vc)
        G_last = G[:, :, -1:, :]
        new_state = (jnp.exp(G_last[:, :, 0, :])[..., None] * state
                     + jnp.einsum('bhsk,bhsv->bhkv', kc * jnp.exp(G_last - G), vc))
        return new_state, o_inter + o_intra

    state0 = jnp.zeros((bsz, A_HEADS, A_DK, A_DV), f32)
    _, o = lax.scan(chunk_step, state0,
                    (to_chunks(q, A_DK), to_chunks(k, A_DK), to_chunks(v, A_DV), to_chunks(log_f, A_DK)))
    o = o.transpose(1, 0, 3, 2, 4).reshape(bsz, -1, A_HEADS, A_DV)[:, META_PAD:]
    gate = jax.nn.silu(g_raw.astype(f32)).reshape(bsz, seq_len, A_HEADS, A_DV)
    o = rms_norm(o) * norm_w.astype(f32) * gate
    return o.reshape(bsz, seq_len, A_WIDTH)


def causal_depthwise_conv(x, w, b):
    out = lax.conv_general_dilated(x, w[:, None, :], window_strides=(1,),
                                   padding=[(B_CONV - 1, 0)],
                                   dimension_numbers=('NWC', 'WIO', 'NWC'),
                                   feature_group_count=x.shape[-1])
    return out + b


def segsum(a):
    T = a.shape[-1]
    cs = jnp.cumsum(a, axis=-1)
    diff = cs[..., :, None] - cs[..., None, :]
    mask = jnp.tril(jnp.ones((T, T), dtype=bool))
    return jnp.where(mask, diff, -jnp.inf)


def ssd_chunked(xdt, dA, b_h, c_h):
    a_cum = jnp.cumsum(dA, axis=-1)
    l_mat = jnp.exp(segsum(dA))
    scores = jnp.einsum('bclhn,bcshn->bhcls', c_h, b_h) * l_mat
    y_diag = jnp.einsum('bhcls,bcshp->bclhp', scores, xdt)
    decay_states = jnp.exp(a_cum[..., -1:] - a_cum)
    states = jnp.einsum('bclhn,bhcl,bclhp->bchpn', b_h, decay_states, xdt)
    states = jnp.concatenate([jnp.zeros_like(states[:, :1]), states], axis=1)
    chunk_decay = jnp.exp(segsum(jnp.pad(a_cum[..., -1], ((0, 0), (0, 0), (1, 0)))))
    new_states = jnp.einsum('bhzc,bchpn->bzhpn', chunk_decay, states)
    prev_states = new_states[:, :-1]
    y_off = jnp.einsum('bclhn,bchpn,bhcl->bclhp', c_h, prev_states, jnp.exp(a_cum))
    return y_diag + y_off


def mamba2_mixer(z, xbc, dt_raw, conv_w, conv_b, dt_bias, a_log, d_skip, norm_w):
    f32 = jnp.float32
    bsz, seq_len, _ = z.shape
    xbc = jax.nn.silu(causal_depthwise_conv(xbc.astype(f32), conv_w.astype(f32), conv_b.astype(f32)))
    xs, b_in, c_in = jnp.split(xbc, [B_WIDTH, B_WIDTH + B_GROUPS * B_DSTATE], axis=-1)
    dt = jax.nn.softplus(dt_raw.astype(f32) + dt_bias.astype(f32))
    a = -jnp.exp(a_log.astype(f32))
    nc = (seq_len + META_PAD) // CHUNK
    rep = B_HEADS // B_GROUPS
    xs = pad_front(xs).reshape(bsz, nc, CHUNK, B_HEADS, B_HEADDIM)
    b_h = jnp.repeat(pad_front(b_in).reshape(bsz, nc, CHUNK, B_GROUPS, B_DSTATE), rep, axis=3)
    c_h = jnp.repeat(pad_front(c_in).reshape(bsz, nc, CHUNK, B_GROUPS, B_DSTATE), rep, axis=3)
    dt = pad_front(dt).reshape(bsz, nc, CHUNK, B_HEADS)
    dA = (dt * a).transpose(0, 3, 1, 2)
    y = ssd_chunked(xs * dt[..., None], dA, b_h, c_h) + d_skip.astype(f32)[:, None] * xs
    y = y.reshape(bsz, -1, B_WIDTH)[:, META_PAD:]
    y = y * jax.nn.silu(z.astype(f32))
    y = rms_norm(y.reshape(bsz, seq_len, B_GROUPS, B_WIDTH // B_GROUPS)).reshape(bsz, seq_len, B_WIDTH)
    return y * norm_w.astype(f32)


def s5_mixer(u, a_re, a_im, log_dt, b_re, b_im, c_re, c_im, d_skip, glu_w, glu_b):
    f32 = jnp.float32
    bsz, seq_len, _ = u.shape
    uf = u.astype(f32)
    lam_re = jnp.minimum(a_re.astype(f32), S5_MAX_RE)
    lam_im = a_im.astype(f32)
    dt = jnp.exp(log_dt.astype(f32))[:, None]
    mag = jnp.exp(lam_re * dt)
    lb_re = mag * jnp.cos(lam_im * dt)
    lb_im = mag * jnp.sin(lam_im * dt)
    den = jnp.square(lam_re) + jnp.square(lam_im)
    nr = lb_re - 1.0
    s_re = (nr * lam_re + lb_im * lam_im) / den
    s_im = (lb_im * lam_re - nr * lam_im) / den
    br = b_re.astype(f32)
    bi = b_im.astype(f32)
    bb_re = s_re[..., None] * br - s_im[..., None] * bi
    bb_im = s_re[..., None] * bi + s_im[..., None] * br
    ug = uf.reshape(bsz, seq_len, C_GROUPS, C_GROUP_CH)
    bu_re = jnp.einsum('blgc,gnc->blgn', ug, bb_re)
    bu_im = jnp.einsum('blgc,gnc->blgn', ug, bb_im)
    a_el_re = jnp.broadcast_to(lb_re, bu_re.shape)
    a_el_im = jnp.broadcast_to(lb_im, bu_im.shape)

    def combine(e1, e2):
        a1r, a1i, b1r, b1i = e1
        a2r, a2i, b2r, b2i = e2
        return (a2r * a1r - a2i * a1i, a2r * a1i + a2i * a1r,
                a2r * b1r - a2i * b1i + b2r, a2r * b1i + a2i * b1r + b2i)

    _, _, x_re, x_im = lax.associative_scan(combine, (a_el_re, a_el_im, bu_re, bu_im), axis=1)
    y = (jnp.einsum('blgn,gcn->blgc', x_re, c_re.astype(f32))
         - jnp.einsum('blgn,gcn->blgc', x_im, c_im.astype(f32)))
    y = y.reshape(bsz, seq_len, C_WIDTH) + d_skip.astype(f32) * uf
    y = jax.nn.gelu(y)
    return y * jax.nn.sigmoid(y @ glu_w.astype(f32) + glu_b.astype(f32))


def setup_inputs(seed: int = 0) -> dict:
    key = jax.random.key(seed)
    ks = jax.random.split(key, 32)
    f32 = jnp.float32

    def nrm(k, shape, scale):
        return scale * jax.random.normal(k, shape, f32)

    dt0 = jnp.exp(jax.random.uniform(ks[6], (DEPTH, B_HEADS), f32, math.log(1e-3), math.log(1e-1)))
    s5_a_im = (math.pi * jnp.arange(C_STATE, dtype=f32))[None, None, :] + nrm(ks[11], (DEPTH, C_GROUPS, C_STATE), 0.01)
    return {
        'x': nrm(ks[0], (BATCH, SEQ, D_MODEL), 1.0),
        'meta_tokens': nrm(ks[1], (N_META, D_MODEL), 1.0),
        'w_in': nrm(ks[2], (DEPTH, D_MODEL, D_IN), D_MODEL ** -0.5),
        'hgrn_lb_logits': nrm(ks[3], (DEPTH, A_WIDTH), 0.1),
        'hgrn_norm_w': 1.0 + nrm(ks[4], (DEPTH, A_DV), 0.02),
        'm2_conv_w': nrm(ks[5], (DEPTH, B_CONV, B_CONV_DIM), B_CONV ** -0.5),
        'm2_conv_b': nrm(ks[7], (DEPTH, B_CONV_DIM), 0.02),
        'm2_dt_bias': dt0 + jnp.log(-jnp.expm1(-dt0)),
        'm2_a_log': jnp.log(jax.random.uniform(ks[8], (DEPTH, B_HEADS), f32, 1.0, 16.0)),
        'm2_d': 1.0 + nrm(ks[9], (DEPTH, B_HEADS), 0.1),
        'm2_norm_w': 1.0 + nrm(ks[10], (DEPTH, B_WIDTH), 0.02),
        's5_a_re': -0.5 + nrm(ks[12], (DEPTH, C_GROUPS, C_STATE), 0.01),
        's5_a_im': s5_a_im,
        's5_log_dt': jax.random.uniform(ks[13], (DEPTH, C_GROUPS), f32, math.log(1e-3), math.log(1e-1)),
        's5_b_re': nrm(ks[14], (DEPTH, C_GROUPS, C_STATE, C_GROUP_CH), (2 * C_GROUP_CH) ** -0.5),
        's5_b_im': nrm(ks[15], (DEPTH, C_GROUPS, C_STATE, C_GROUP_CH), (2 * C_GROUP_CH) ** -0.5),
        's5_c_re': nrm(ks[16], (DEPTH, C_GROUPS, C_GROUP_CH, C_STATE), C_STATE ** -0.5),
        's5_c_im': nrm(ks[17], (DEPTH, C_GROUPS, C_GROUP_CH, C_STATE), C_STATE ** -0.5),
        's5_d': nrm(ks[18], (DEPTH, C_WIDTH), 1.0),
        's5_glu_w': nrm(ks[19], (DEPTH, C_WIDTH, C_WIDTH), C_WIDTH ** -0.5),
        's5_glu_b': nrm(ks[20], (DEPTH, C_WIDTH), 0.02),
        'w_out': nrm(ks[21], (DEPTH, D_MIX, D_MODEL), BETA * D_MIX ** -0.5),
        'ln1_g': 1.0 + nrm(ks[22], (DEPTH, D_MODEL), 0.02),
        'ln1_b': nrm(ks[23], (DEPTH, D_MODEL), 0.02),
        'w_mlp_in': nrm(ks[24], (DEPTH, D_MODEL, D_FF), D_MODEL ** -0.5),
        'w_mlp_out': nrm(ks[25], (DEPTH, D_FF, D_MODEL), BETA * D_FF ** -0.5),
        'ln2_g': 1.0 + nrm(ks[26], (DEPTH, D_MODEL), 0.02),
        'ln2_b': nrm(ks[27], (DEPTH, D_MODEL), 0.02),
    }


def reference(x, meta_tokens, w_in, hgrn_lb_logits, hgrn_norm_w, m2_conv_w, m2_conv_b,
              m2_dt_bias, m2_a_log, m2_d, m2_norm_w, s5_a_re, s5_a_im, s5_log_dt,
              s5_b_re, s5_b_im, s5_c_re, s5_c_im, s5_d, s5_glu_w, s5_glu_b, w_out,
              ln1_g, ln1_b, w_mlp_in, w_mlp_out, ln2_g, ln2_b):
    bsz = x.shape[0]
    meta = jnp.broadcast_to(meta_tokens.astype(x.dtype)[None], (bsz, N_META, D_MODEL))
    h = jnp.concatenate([meta, x], axis=1)
    lb_cum = jnp.cumsum(jax.nn.softmax(hgrn_lb_logits.astype(jnp.float32), axis=0), axis=0)
    lower_bounds = lb_cum - lb_cum[0]
    split_idx = np.cumsum(SPLITS)[:-1].tolist()
    for l in range(DEPTH):
        proj = h @ w_in[l]
        q_a, f_a, i_a, g_a, z_b, xbc_b, dt_b, u_c = jnp.split(proj, split_idx, axis=-1)
        y_a = hgrn2_mixer(q_a, f_a, i_a, g_a, lower_bounds[l], hgrn_norm_w[l])
        y_b = mamba2_mixer(z_b, xbc_b, dt_b, m2_conv_w[l], m2_conv_b[l], m2_dt_bias[l],
                           m2_a_log[l], m2_d[l], m2_norm_w[l])
        y_c = s5_mixer(u_c, s5_a_re[l], s5_a_im[l], s5_log_dt[l], s5_b_re[l], s5_b_im[l],
                       s5_c_re[l], s5_c_im[l], s5_d[l], s5_glu_w[l], s5_glu_b[l])
        mixed = jnp.concatenate([y_a, y_b, y_c], axis=-1).astype(h.dtype) @ w_out[l]
        h = layer_norm(ALPHA * h + mixed, ln1_g[l], ln1_b[l])
        ff = jnp.square(jax.nn.relu(h @ w_mlp_in[l])) @ w_mlp_out[l]
        h = layer_norm(ALPHA * h + ff, ln2_g[l], ln2_b[l])
    return h[:, N_META:]
```

```cpp
#include <hip/hip_runtime.h>
#include <hip/hip_cooperative_groups.h>
#include <cstdio>
namespace cg = cooperative_groups;

#ifndef COOP
#define COOP 1
#endif

#define LAS __attribute__((address_space(3)))
typedef unsigned short bf16_t;
typedef short bf16x8 __attribute__((ext_vector_type(8)));
typedef float f32x4 __attribute__((ext_vector_type(4)));
typedef float f32x2 __attribute__((ext_vector_type(2)));
typedef unsigned u32x4 __attribute__((ext_vector_type(4)));
typedef unsigned u32x2 __attribute__((ext_vector_type(2)));

constexpr int DM = 1024, NBATCH = 4, SEQ = 4096, DEPTH = 4;
constexpr int LP = 4160, MR = 16640, NCHB = 65, NCHT = 260, PADR = 48;
constexpr int NPROJ = 3072, NINP = 3328, DFF = 4096, DIN = 3078;
constexpr int C_F = 384, C_I = 768, C_G = 1152, C_Z = 1536, C_X = 1920, C_B = 2304, C_C = 2560, C_U = 2816;
constexpr float ALPHA = 1.681792830507429f;
constexpr float LN_EPS = 1e-5f, RMS_EPS = 1e-6f;
constexpr int NTHR = 512;
constexpr int LDS_BYTES = 147456;
constexpr int RS_OFF = 131072;

constexpr size_t WS_PROJ = 0, WS_HID = 0;
constexpr size_t WS_MIXED = 102236160;
constexpr size_t WS_PRE = 136314880;
constexpr size_t WS_STH = 204472320;
constexpr size_t WS_STM = 217251840;
constexpr size_t WS_STS = 242810880;
constexpr size_t WS_DECH = 244940800;
constexpr size_t WS_DECM = 245340160;
constexpr size_t WS_DT = 245348352;
constexpr size_t WS_STAT0 = 245880832;
constexpr size_t WS_STAT1 = 248010752;
constexpr size_t WS_C1IN = 250140672;
constexpr size_t WS_C2IN = WS_C1IN + 13312;
constexpr size_t WS_C1MLP = WS_C2IN + 13312;
constexpr size_t WS_C2MLP = WS_C1MLP + 16384;
constexpr size_t WS_LB = WS_C2MLP + 16384;
constexpr size_t WS_S5LAM = WS_LB + 2048;
constexpr size_t WS_S5BB = WS_S5LAM + 16384;
constexpr size_t WS_S5C = WS_S5BB + 131072;
constexpr size_t WS_GLUT = WS_S5C + 65536;
constexpr size_t WS_BAR = WS_GLUT + 131072;
constexpr size_t WS_S5BBH = WS_BAR + 16384;
constexpr size_t WS_TBL = WS_S5BBH + 65536;
constexpr size_t T_LB = 0, T_S5LAM = 2048, T_S5BBH = 18432, T_S5C = 83968, T_GLUT = 149504, TBL_STRIDE = 280576;
#define TBL(off, l) (WS_TBL + (size_t)(l) * TBL_STRIDE + (off))
constexpr size_t WS_END = WS_TBL + 4 * TBL_STRIDE;
constexpr size_t OUT_XB = 0, OUT_WIN = 34078720, OUT_WOUT = 40894464, OUT_W1 = 42991616, OUT_W2 = 51380224;

struct Params { const float* in[28]; float* out; unsigned char* ws; int ph_lo, ph_hi; };
struct KPtr { const __attribute__((address_space(4))) Params* q; };
typedef const KPtr KP;
#define p (*P_.q)

typedef __bf16 bf16v2 __attribute__((ext_vector_type(2)));
__device__ __forceinline__ unsigned cvt_pk_bf16(float lo, float hi) { const bf16v2 v = __builtin_convertvector((f32x2){lo, hi}, bf16v2); return __builtin_bit_cast(unsigned, v); }
__device__ __forceinline__ bf16_t f2bf(float f) { return (bf16_t)(cvt_pk_bf16(f, 0.f) & 0xffffu); }
__device__ __forceinline__ float bf2f(bf16_t b) { return __uint_as_float(((unsigned)b) << 16); }
__device__ __forceinline__ float bflo(unsigned w) { return __uint_as_float(w << 16); }
__device__ __forceinline__ float bfhi(unsigned w) { return __uint_as_float(w & 0xffff0000u); }
__device__ __forceinline__ void unpack8(const u32x4 v, float* o) { o[0] = bflo(v.x); o[1] = bfhi(v.x); o[2] = bflo(v.y); o[3] = bfhi(v.y); o[4] = bflo(v.z); o[5] = bfhi(v.z); o[6] = bflo(v.w); o[7] = bfhi(v.w); }
__device__ __forceinline__ u32x4 pack8(const float* o) { u32x4 v; v.x = cvt_pk_bf16(o[0], o[1]); v.y = cvt_pk_bf16(o[2], o[3]); v.z = cvt_pk_bf16(o[4], o[5]); v.w = cvt_pk_bf16(o[6], o[7]); return v; }
__device__ __forceinline__ u32x2 pack4(const f32x4 a) { u32x2 v; v.x = cvt_pk_bf16(a[0], a[1]); v.y = cvt_pk_bf16(a[2], a[3]); return v; }
__device__ __forceinline__ float sigmoidf_(float x) { return __builtin_amdgcn_rcpf(1.0f + __expf(-x)); }
__device__ __forceinline__ float siluf_(float x) { return x * __builtin_amdgcn_rcpf(1.0f + __expf(-x)); }
__device__ __forceinline__ float softplusf_(float x) { return x > 20.f ? x : log1pf(expf(x)); }
__device__ __forceinline__ float gelu_tanh(float x) { const float e = __builtin_amdgcn_exp2f(x * (-2.302208198f - 0.102943240f * x * x)); return x * __builtin_amdgcn_rcpf(1.0f + e); }
__device__ __forceinline__ int tidx() { int t = threadIdx.x; asm volatile("" : "+v"(t)); return t; }
#define LBAR() do { asm volatile("s_waitcnt lgkmcnt(0)" ::: "memory"); __builtin_amdgcn_s_barrier(); asm volatile("" ::: "memory"); } while (0)
#define MFMA16(a, b, c) __builtin_amdgcn_mfma_f32_16x16x32_bf16((a), (b), (c), 0, 0, 0)

__device__ void phase_init(KP& P_) {
    const float* x = p.in[0]; const float* meta = p.in[1];
    bf16_t* xb = (bf16_t*)(p.ws + WS_PRE);
    const size_t total = (size_t)MR * 256, GT = (size_t)gridDim.x * NTHR;
    for (size_t i0 = (size_t)blockIdx.x * NTHR + tidx(); i0 < total; i0 += 4 * GT) {
        f32x4 v[4];
#pragma unroll
        for (int q = 0; q < 4; ++q) { const size_t i = i0 + q * GT; v[q] = (f32x4){0.f, 0.f, 0.f, 0.f};
            if (i < total) { const int row = (int)(i >> 8), c4 = (int)(i & 255) * 4; const int b = row / LP, r = row - b * LP;
                if (r >= 64) v[q] = *(const f32x4*)(x + ((size_t)(b * SEQ + r - 64)) * DM + c4);
                else if (r >= PADR) v[q] = *(const f32x4*)(meta + (size_t)(r - PADR) * DM + c4); } }
#pragma unroll
        for (int q = 0; q < 4; ++q) { const size_t i = i0 + q * GT; if (i < total) { const int row = (int)(i >> 8), c4 = (int)(i & 255) * 4; *(u32x2*)(xb + (size_t)row * DM + c4) = pack4(v[q]); } }
    }
}

__device__ void conv_unit(LAS unsigned char* lds, const float* src, int ld, int sn0, int nvalid, int k0, int krows,
                          bf16_t* dst, int dn0, int Kdst, int kd0, const float* gs, const float* bs, float* c1, float* c2) {
    LAS bf16_t* T = (LAS bf16_t*)lds;
    LAS float* red = (LAS float*)(lds + 9216);
    const int tid = tidx(), kl = tid >> 3, ng = (tid & 7) * 8;
    float a1[8], a2[8], wn[8], gn, bn;
#pragma unroll
    for (int j = 0; j < 8; ++j) { a1[j] = 0.f; a2[j] = 0.f; }
    const int nkt = krows / 64;
    { const int k = k0 + kl; gn = gs ? gs[k] : 1.f; bn = bs ? bs[k] : 0.f;
#pragma unroll
      for (int j = 0; j < 8; ++j) wn[j] = (ng + j < nvalid) ? src[(size_t)k * ld + sn0 + ng + j] : 0.f; }
    for (int kt = 0; kt < nkt; ++kt) {
        float w[8]; const float g = gn, b = bn;
#pragma unroll
        for (int j = 0; j < 8; ++j) w[j] = wn[j];
        if (kt + 1 < nkt) { const int k = k0 + (kt + 1) * 64 + kl; gn = gs ? gs[k] : 1.f; bn = bs ? bs[k] : 0.f;
#pragma unroll
            for (int j = 0; j < 8; ++j) wn[j] = (ng + j < nvalid) ? src[(size_t)k * ld + sn0 + ng + j] : 0.f; }
#pragma unroll
        for (int j = 0; j < 8; ++j) { const bf16_t wb = f2bf(w[j] * g); a1[j] += bf2f(wb); a2[j] += b * w[j]; T[(ng + j) * 72 + kl] = wb; }
        LBAR();
        { const int n = tid >> 3, ks = (tid & 7) * 8; const u32x4 v = *(const LAS u32x4*)(T + n * 72 + ks);
          *(u32x4*)(dst + (size_t)(dn0 + n) * Kdst + kd0 + kt * 64 + ks) = v; }
        LBAR();
    }
    if (c1) {
#pragma unroll
        for (int j = 0; j < 8; ++j) red[kl * 65 + ng + j] = a1[j];
        LBAR();
        if (tid < 64) { float sm = 0.f; for (int q = 0; q < 64; ++q) sm += red[q * 65 + tid]; c1[dn0 + tid] = sm; }
        LBAR();
#pragma unroll
        for (int j = 0; j < 8; ++j) red[kl * 65 + ng + j] = a2[j];
        LBAR();
        if (tid < 64) { float sm = 0.f; for (int q = 0; q < 64; ++q) sm += red[q * 65 + tid]; c2[dn0 + tid] = sm; }
        LBAR();
    }
}

__device__ void weights_units(LAS unsigned char* lds, KP& P0, int lm0, int li0, int ufirst, int ustride, int m_lo, int m_hi) {
    const int n_m = lm0 >= 0 ? m_hi - m_lo : 0, n_i = li0 >= 0 ? 49 : 0, NU = n_m + n_i;
    for (int uu = ufirst; uu < NU; uu += ustride) {
        const int u = uu < n_m ? uu + m_lo : uu - n_m + 144;
        KPtr P_ = P0; int lm = __builtin_amdgcn_readfirstlane(lm0), li = __builtin_amdgcn_readfirstlane(li0); asm volatile("" : "+s"(P_.q), "+s"(lm), "+s"(li));
        unsigned char* ob = (unsigned char*)p.out; unsigned char* ws = p.ws;
        if (u < 144) {
            if (u < 64) { const float* w1 = p.in[24] + (size_t)lm * DM * DFF;
                conv_unit(lds, w1, DFF, u * 64, 64, 0, 1024, (bf16_t*)(ob + OUT_W1), u * 64, 1024, 0, p.in[22] + (size_t)lm * DM, p.in[23] + (size_t)lm * DM, (float*)(ws + WS_C1MLP), (float*)(ws + WS_C2MLP)); }
            else if (u < 128) { const int j = (u - 64) & 15, kq = (u - 64) >> 4; const float* w2 = p.in[25] + (size_t)lm * DFF * DM;
                conv_unit(lds, w2, DM, j * 64, 64, kq * 1024, 1024, (bf16_t*)(ob + OUT_W2), j * 64, DFF, kq * 1024, nullptr, nullptr, nullptr, nullptr); }
            else { const int j = u - 128; const float* w_out = p.in[21] + (size_t)lm * DM * DM;
                conv_unit(lds, w_out, DM, j * 64, 64, 0, 1024, (bf16_t*)(ob + OUT_WOUT), j * 64, 1024, 0, nullptr, nullptr, nullptr, nullptr); }
        } else {
            const int j = u - 144; int sn0, nvalid = 64;
            if (j < 44) sn0 = j * 64; else if (j < 48) sn0 = 2822 + (j - 44) * 64; else { sn0 = 2816; nvalid = 6; }
            const float* w_in = p.in[2] + (size_t)li * DM * DIN;
            const float* g_in = li > 0 ? p.in[26] + (size_t)(li - 1) * DM : nullptr; const float* b_in = li > 0 ? p.in[27] + (size_t)(li - 1) * DM : nullptr;
            conv_unit(lds, w_in, DIN, sn0, nvalid, 0, 1024, (bf16_t*)(ob + OUT_WIN), j * 64, 1024, 0, g_in, b_in, (float*)(ws + WS_C1IN), (float*)(ws + WS_C2IN));
        }
    }
}
__device__ void tables_units(LAS unsigned char* lds, KP& P0, int l0, int wg0) {
    const int G = gridDim.x;
    for (int u = ((int)blockIdx.x - wg0 + G) % G; u < 7; u += G) {
        KPtr P_ = P0; int l = l0; asm volatile("" : "+s"(P_.q), "+s"(l));
        unsigned char* ws = p.ws;
        if (u < 4) conv_unit(lds, p.in[19] + (size_t)l * 65536, 256, u * 64, 64, 0, 256, (bf16_t*)(ws + TBL(T_GLUT, l)), u * 64, 256, 0, nullptr, nullptr, nullptr, nullptr);
        else if (u < 6) {
            const int id = (u - 4) * 512 + tidx(), g = id >> 6, n = id & 63; const int gi = (l * 16 + g) * 64 + n;
            const float lre = fminf(p.in[11][gi], -1e-4f), lim = p.in[12][gi], dt = expf(p.in[13][l * 16 + g]);
            const float mag = expf(lre * dt); const float lbr = mag * cosf(lim * dt), lbi = mag * sinf(lim * dt);
            const float den = lre * lre + lim * lim, nr = lbr - 1.0f;
            const float sre = (nr * lre + lbi * lim) / den, sim = (lbi * lre - nr * lim) / den;
            float pr = lbr, pi = lbi;
            for (int q = 0; q < 6; ++q) { const float t = pr * pr - pi * pi; pi = 2.f * pr * pi; pr = t; }
            float* lam = (float*)(ws + TBL(T_S5LAM, l)) + (size_t)(g * 64 + n) * 4; lam[0] = lbr; lam[1] = lbi; lam[2] = pr; lam[3] = pi;
            float bb[32];
            bf16_t* bbh = (bf16_t*)(ws + TBL(T_S5BBH, l)) + (size_t)(g * 128 + 2 * n) * 16;
            for (int c = 0; c < 16; ++c) { const float br = p.in[14][(size_t)gi * 16 + c], bi = p.in[15][(size_t)gi * 16 + c]; bb[c] = sre * br - sim * bi; bb[16 + c] = sre * bi + sim * br; bbh[c] = f2bf(bb[c]); bbh[16 + c] = f2bf(bb[16 + c]); }
            bf16_t* cm = (bf16_t*)(ws + TBL(T_S5C, l));
            for (int c = 0; c < 16; ++c) { const size_t ci = ((size_t)(l * 16 + g) * 16 + c) * 64 + n; cm[(size_t)(g * 16 + c) * 128 + 2 * n] = f2bf(p.in[16][ci]); cm[(size_t)(g * 16 + c) * 128 + 2 * n + 1] = f2bf(-p.in[17][ci]); }
        } else {
            if (tidx() < 384) { const int c = tidx(); float v[4], mx = -1e30f; for (int q = 0; q < 4; ++q) { v[q] = p.in[3][q * 384 + c]; mx = fmaxf(mx, v[q]); }
                float sm = 0.f; for (int q = 0; q < 4; ++q) { v[q] = expf(v[q] - mx); sm += v[q]; } float a = 0.f; for (int q = 1; q <= l; ++q) a += v[q] / sm;
                ((float*)(ws + TBL(T_LB, l)))[c] = a; }
        }
    }
}

constexpr int HTB = 16384;
__device__ __forceinline__ int lds_byte(int r, int c) { const int st = (r >> 4) * 2 + (c >> 5), rr = r & 15, cc = c & 31, ob = rr * 64 + cc * 2; return st * 1024 + (ob ^ (((ob >> 9) & 1) << 5)); }
__device__ __forceinline__ void stage_rc(int b, int& R, int& C) { const int st = b / 1024, sb = b % 1024, swz = sb ^ (((sb >> 9) & 1) << 5); R = (st >> 1) * 16 + swz / 64; C = (st & 1) * 32 + (swz % 64) / 2; }

struct RowInfo { float mu, rstd; int pad; };

__device__ __forceinline__ int prow0(int pm) { return (pm >> 4) * LP + PADR + (pm & 15) * 256; }
__device__ __forceinline__ int trow(int i) { return (i >> 4) * LP + 4144 + (i & 15); }
__device__ __forceinline__ void prep_rowstats(const float* stat, int pm, int par, LAS unsigned char* lds) {
    const int t = tidx();
    if (t < (pm < 64 ? 256 : 64)) {
        const int row = pm < 64 ? prow0(pm) + t : trow(t); const f32x4* sp = (const f32x4*)(stat + (size_t)row * 32);
        float s1 = 0.f, s2 = 0.f;
#pragma unroll
        for (int q = 0; q < 8; ++q) { const f32x4 v = sp[q]; s1 += v[0] + v[2]; s2 += v[1] + v[3]; }
        const float mu = s1 * (1.0f / 1024.0f); const float var = fmaxf(s2 * (1.0f / 1024.0f) - mu * mu, 0.f);
        ((LAS f32x2*)(lds + RS_OFF + par * 2048))[t] = (f32x2){mu, __builtin_amdgcn_rsqf(var + LN_EPS)};
    }
}

struct ColInfo { f32x4 a, b; };
struct EpiInProj {
    static constexpr bool STATS = false, PRELOAD = false;
    const float* stat; const float* c1; const float* c2; bf16_t* proj; float* dtbuf; const float* dtbias; float* stat_out; int fold;
    __device__ __forceinline__ void prep(int pm, int par, LAS unsigned char* lds) const { if (fold) prep_rowstats(stat, pm, par, lds); }
    __device__ __forceinline__ RowInfo rowinfo(int row, int lrow, int par, LAS unsigned char* lds) const {
        RowInfo r; r.mu = 0.f; r.rstd = 1.f; if (fold) { const f32x2 sv = ((const LAS f32x2*)(lds + RS_OFF + par * 2048))[lrow]; r.mu = sv.x; r.rstd = sv.y; }
        r.pad = 0; return r; }
    __device__ __forceinline__ ColInfo colinfo(int col) const { ColInfo c; c.a = (f32x4){0.f, 0.f, 0.f, 0.f}; c.b = c.a; if (fold) { c.a = *(const f32x4*)(c1 + col); c.b = *(const f32x4*)(c2 + col); } return c; }
    __device__ __forceinline__ f32x4 preload(int row, int col) const { return (f32x4){0.f, 0.f, 0.f, 0.f}; }
    __device__ __forceinline__ u32x2 preload_pk(int row, int col) const { return (u32x2){0u, 0u}; }
    __device__ __forceinline__ void apply(const RowInfo& ri, const ColInfo& ci, int row, int col, f32x4 a, f32x4 pv, float& s1, float& s2) const {
        f32x4 v = a;
        if (fold) v = (a - ci.a * ri.mu) * ri.rstd + ci.b;
        if (ri.pad) v = (f32x4){0.f, 0.f, 0.f, 0.f};
        *(u32x2*)(proj + (size_t)row * NPROJ + col) = pack4(v);
    }
};
struct EpiResid {
    static constexpr bool STATS = true, PRELOAD = true;
    const float* stat; const float* g; const float* b; bf16_t* xb; float* stat_out; int ident;
    __device__ __forceinline__ void prep(int pm, int par, LAS unsigned char* lds) const { if (!ident) prep_rowstats(stat, pm, par, lds); }
    __device__ __forceinline__ RowInfo rowinfo(int row, int lrow, int par, LAS unsigned char* lds) const {
        RowInfo r; r.mu = 0.f; r.rstd = 1.f; r.pad = 0; if (!ident) { const f32x2 sv = ((const LAS f32x2*)(lds + RS_OFF + par * 2048))[lrow]; r.mu = sv.x; r.rstd = sv.y; } return r; }
    __device__ __forceinline__ ColInfo colinfo(int col) const { ColInfo c; c.a = (f32x4){0.f, 0.f, 0.f, 0.f}; c.b = c.a; return c; }
    __device__ __forceinline__ f32x4 preload(int row, int col) const { const u32x2 w = *(const u32x2*)(xb + (size_t)row * DM + col); return (f32x4){bflo(w.x), bfhi(w.x), bflo(w.y), bfhi(w.y)}; }
    __device__ __forceinline__ u32x2 preload_pk(int row, int col) const { return *(const u32x2*)(xb + (size_t)row * DM + col); }
    __device__ __forceinline__ void apply(const RowInfo& ri, const ColInfo& ci, int row, int col, f32x4 a, f32x4 pv, float& s1, float& s2) const {
        f32x4 h = pv;
        if (!ident) { const f32x4 gg = *(const f32x4*)(g + col), bb = *(const f32x4*)(b + col); h = (pv - ri.mu) * ri.rstd * gg + bb; }
        const f32x4 v = h * ALPHA + a;
        *(u32x2*)(xb + (size_t)row * DM + col) = pack4(v);
        s1 += (v[0] + v[1]) + (v[2] + v[3]); s2 += (v[0] * v[0] + v[1] * v[1]) + (v[2] * v[2] + v[3] * v[3]);
    }
};
struct EpiMlpIn {
    static constexpr bool STATS = false, PRELOAD = false;
    const float* stat; const float* c1; const float* c2; bf16_t* hid; float* stat_out;
    __device__ __forceinline__ void prep(int pm, int par, LAS unsigned char* lds) const { prep_rowstats(stat, pm, par, lds); }
    __device__ __forceinline__ RowInfo rowinfo(int row, int lrow, int par, LAS unsigned char* lds) const {
        RowInfo r; const f32x2 sv = ((const LAS f32x2*)(lds + RS_OFF + par * 2048))[lrow]; r.mu = sv.x; r.rstd = sv.y; r.pad = 0; return r; }
    __device__ __forceinline__ ColInfo colinfo(int col) const { ColInfo c; c.a = *(const f32x4*)(c1 + col); c.b = *(const f32x4*)(c2 + col); return c; }
    __device__ __forceinline__ f32x4 preload(int row, int col) const { return (f32x4){0.f, 0.f, 0.f, 0.f}; }
    __device__ __forceinline__ u32x2 preload_pk(int row, int col) const { return (u32x2){0u, 0u}; }
    __device__ __forceinline__ void apply(const RowInfo& ri, const ColInfo& ci, int row, int col, f32x4 a, f32x4 pv, float& s1, float& s2) const {
        f32x4 v = (a - ci.a * ri.mu) * ri.rstd + ci.b;
#pragma unroll
        for (int j = 0; j < 4; ++j) { const float r = fmaxf(v[j], 0.f); v[j] = r * r; }
        *(u32x2*)(hid + (size_t)row * DFF + col) = pack4(v);
    }
};

template <class Epi>
__device__ __forceinline__ void gemm_phase(LAS unsigned char* lds, const bf16_t* Ag, const bf16_t* Btg, const int K, const int nM, const int nN, const Epi& E) {
    const int tid = tidx(), wid = __builtin_amdgcn_readfirstlane(tid >> 6), lane = tid & 63, wr = wid >> 2, wc = wid & 3, fr = lane & 15, fq = lane >> 4;
    const int nt = K / 64, G = gridDim.x, nunits = nM * nN;
    int u = blockIdx.x; if (u >= nunits) return;
    unsigned voff[2];
#pragma unroll
    for (int i = 0; i < 2; ++i) { int R, C; stage_rc(tid * 16 + i * 8192, R, C); voff[i] = (unsigned)(R * K + C) * 2u; }
    const size_t kstep = 128, hstep = (size_t)128 * K * 2, tstep = 2 * hstep;
    const unsigned ldsw = (unsigned)wid * 1024u;
    const int aoff = lds_byte(wr * 64 + fr, fq * 8), boff = lds_byte(wc * 32 + fr, fq * 8);
#define G_SA(b, h) (((b) * 2 + (h)) * HTB)
#define G_SB(b, h) ((4 + (b) * 2 + (h)) * HTB)
#define G_STAGE(bufoff, gbase) do { _Pragma("unroll") for (int _i = 0; _i < 2; ++_i) \
        __builtin_amdgcn_global_load_lds((const unsigned*)((const char*)(gbase) + voff[_i]), (LAS unsigned*)(lds + (bufoff) + ldsw + _i * 8192), 16, 0, 0); } while (0)
#define G_LDA(dst, b, h) do { _Pragma("unroll") for (int m = 0; m < 4; ++m) _Pragma("unroll") for (int k = 0; k < 2; ++k) dst[m][k] = *(const LAS bf16x8*)(lds + G_SA(b, h) + aoff + m * 2048 + k * 1024); } while (0)
#define G_LDB(dst, b, h) do { _Pragma("unroll") for (int n = 0; n < 2; ++n) _Pragma("unroll") for (int k = 0; k < 2; ++k) dst[n][k] = *(const LAS bf16x8*)(lds + G_SB(b, h) + boff + n * 2048 + k * 1024); } while (0)
#define G_MMA(ai, bj, At, Bt) do { __builtin_amdgcn_s_setprio(1); _Pragma("unroll") for (int m = 0; m < 4; ++m) _Pragma("unroll") for (int n = 0; n < 2; ++n) _Pragma("unroll") for (int k = 0; k < 2; ++k) \
        acc[ai][bj][m][n] = MFMA16(Bt[n][k], At[m][k], acc[ai][bj][m][n]); __builtin_amdgcn_s_setprio(0); } while (0)
#define G_WAIT_V(n) asm volatile("s_waitcnt vmcnt(" #n ")" ::: "memory")
#define G_WAIT_L(n) asm volatile("s_waitcnt lgkmcnt(" #n ")" ::: "memory")
#define G_BAR __builtin_amdgcn_s_barrier()
#define G_SCHED __builtin_amdgcn_sched_barrier(0)
    int pm = u % nM, pn = u / nM, par = 0;
    f32x4 acc[2][2][4][2];
#pragma unroll
    for (int a = 0; a < 2; ++a)
#pragma unroll
        for (int b = 0; b < 2; ++b)
#pragma unroll
            for (int m = 0; m < 4; ++m)
#pragma unroll
                for (int n = 0; n < 2; ++n) acc[a][b][m][n] = (f32x4){0.f, 0.f, 0.f, 0.f};
    bf16x8 At[4][2], B0[2][2], B1[2][2];
    const size_t rstep = (size_t)K * 2;
    const char* cA = (const char*)Ag + (size_t)prow0(pm) * rstep; const char* cB = (const char*)Btg + (size_t)pn * tstep;
    E.prep(pm, par, lds);
    G_STAGE(G_SB(0, 0), cB); G_STAGE(G_SA(0, 0), cA); G_STAGE(G_SB(0, 1), cB + hstep); G_STAGE(G_SA(0, 1), cA + hstep);
    if (wr == 1) G_BAR;
    G_WAIT_V(4); G_BAR;
    G_STAGE(G_SB(1, 0), cB + kstep); G_STAGE(G_SA(1, 0), cA + kstep); G_STAGE(G_SB(1, 1), cB + hstep + kstep);
    G_WAIT_V(6); G_BAR;
    for (;;) {
        const int un = u + G; const bool has_next = un < nunits; const int pmn = has_next ? un % nM : pm, pnn = has_next ? un / nM : pn;
        const char* nA = has_next ? (const char*)Ag + (size_t)prow0(pmn) * rstep : cA; const char* nB = has_next ? (const char*)Btg + (size_t)pnn * tstep : cB;
        for (int t = 0; t < nt; t += 2) {
            const bool last = (t == nt - 2);
            const char* a1 = cA + (size_t)(t + 1) * kstep;
            const char* a2 = last ? nA : cA + (size_t)(t + 2) * kstep; const char* b2 = last ? nB : cB + (size_t)(t + 2) * kstep;
            const char* a3 = a2 + kstep; const char* b3 = b2 + kstep;
            if (last && has_next && pmn != pm) E.prep(pmn, par ^ 1, lds);
            G_LDB(B0, 0, 0); G_SCHED; G_LDA(At, 0, 0); G_STAGE(G_SA(1, 1), a1 + hstep);
            G_WAIT_L(8); G_BAR; G_WAIT_L(0); G_MMA(0, 0, At, B0); G_BAR; G_SCHED;
            G_LDB(B1, 0, 1); G_STAGE(G_SB(0, 0), b2);
            G_BAR; G_WAIT_L(0); G_MMA(0, 1, At, B1); G_BAR;
            G_LDA(At, 0, 1); G_STAGE(G_SA(0, 0), a2);
            G_BAR; G_WAIT_L(0); G_MMA(1, 0, At, B0); G_BAR; G_SCHED;
            G_STAGE(G_SB(0, 1), b2 + hstep);
            G_WAIT_V(6); G_BAR; G_MMA(1, 1, At, B1); G_BAR;
            G_LDB(B0, 1, 0); G_SCHED; G_LDA(At, 1, 0); G_STAGE(G_SA(0, 1), a2 + hstep);
            G_WAIT_L(8); G_BAR; G_WAIT_L(0); G_MMA(0, 0, At, B0); G_BAR; G_SCHED;
            G_LDB(B1, 1, 1); G_STAGE(G_SB(1, 0), b3);
            G_BAR; G_WAIT_L(0); G_MMA(0, 1, At, B1); G_BAR;
            G_LDA(At, 1, 1); G_STAGE(G_SA(1, 0), a3);
            G_BAR; G_WAIT_L(0); G_MMA(1, 0, At, B0); G_BAR; G_SCHED;
            G_STAGE(G_SB(1, 1), b3 + hstep);
            G_WAIT_V(6); G_BAR; G_MMA(1, 1, At, B1); G_BAR;
        }
        {
            ColInfo ci[2][2];
#pragma unroll
            for (int bj = 0; bj < 2; ++bj)
#pragma unroll
                for (int n = 0; n < 2; ++n) ci[bj][n] = E.colinfo(pn * 256 + bj * 128 + wc * 32 + n * 16 + fq * 4);
            u32x2 pk[4][2][2];
#pragma unroll
            for (int gi = 0; gi < 8; ++gi) {
                const int ai = gi >> 2, m = gi & 3;
                const int lrow = ai * 128 + wr * 64 + m * 16 + fr, row = prow0(pm) + lrow;
                if (!Epi::PRELOAD && gi == 0) {
#pragma unroll
                    for (int g2 = 0; g2 < 4; ++g2)
#pragma unroll
                        for (int bj = 0; bj < 2; ++bj)
#pragma unroll
                            for (int n = 0; n < 2; ++n) pk[g2][bj][n] = (u32x2){0u, 0u};
                }
                if (Epi::PRELOAD && m == 0) {
#pragma unroll
                    for (int g2 = 0; g2 < 4; ++g2)
#pragma unroll
                        for (int bj = 0; bj < 2; ++bj)
#pragma unroll
                            for (int n = 0; n < 2; ++n) pk[g2][bj][n] = E.preload_pk(prow0(pm) + ai * 128 + wr * 64 + g2 * 16 + fr, pn * 256 + bj * 128 + wc * 32 + n * 16 + fq * 4);
                }
                f32x4 pv[2][2];
#pragma unroll
                for (int bj = 0; bj < 2; ++bj)
#pragma unroll
                    for (int n = 0; n < 2; ++n) { const u32x2 w = pk[m][bj][n]; pv[bj][n] = (f32x4){bflo(w.x), bfhi(w.x), bflo(w.y), bfhi(w.y)}; }
                const RowInfo ri = E.rowinfo(row, lrow, par, lds);
                float s1 = 0.f, s2 = 0.f;
#pragma unroll
                for (int bj = 0; bj < 2; ++bj)
#pragma unroll
                    for (int n = 0; n < 2; ++n) E.apply(ri, ci[bj][n], row, pn * 256 + bj * 128 + wc * 32 + n * 16 + fq * 4, acc[ai][bj][m][n], pv[bj][n], s1, s2);
                if (Epi::STATS) {
                    s1 += __shfl_xor(s1, 16); s1 += __shfl_xor(s1, 32); s2 += __shfl_xor(s2, 16); s2 += __shfl_xor(s2, 32);
                    if (fq == 0) *(f32x2*)(E.stat_out + ((size_t)row * 16 + pn * 4 + wc) * 2) = (f32x2){s1, s2};
                }
                asm volatile("" ::: "memory");
            }
        }
        if (!has_next) break;
#pragma unroll
        for (int a = 0; a < 2; ++a)
#pragma unroll
            for (int b = 0; b < 2; ++b)
#pragma unroll
                for (int m = 0; m < 4; ++m)
#pragma unroll
                    for (int n = 0; n < 2; ++n) acc[a][b][m][n] = (f32x4){0.f, 0.f, 0.f, 0.f};
        if (pmn != pm) par ^= 1;
        u = un; pm = pmn; pn = pnn; cA = nA; cB = nB;
    }
    G_WAIT_V(0);
    if (wr == 0) G_BAR;
    G_BAR;
}


template <class Epi>
__device__ __forceinline__ void gemm_tail(LAS unsigned char* lds, const bf16_t* Ag, const bf16_t* Btg, const int K, const int N, const Epi& E, const int ufirst, const int ustride) {
    const int tid = tidx(), wid = tid >> 6, lane = tid & 63, fr = lane & 15, fq = lane >> 4;
    LAS float* red = (LAS float*)lds;
    const int nunits = 4 * (N / 64), ks = K / 8, nch = ks / 128, G = ustride;
    int u = ufirst;
    bf16x8 af[4], bf[4][4];
#define T_LOAD(uu, cc) do { const int _rb = (uu) & 3, _cb = (uu) >> 2; \
        const bf16_t* _ap = Ag + (size_t)trow(_rb * 16 + fr) * K + wid * ks + (cc) * 128 + fq * 8; \
        const bf16_t* _bp = Btg + (size_t)(_cb * 64 + fr) * K + wid * ks + (cc) * 128 + fq * 8; \
        _Pragma("unroll") for (int s_ = 0; s_ < 4; ++s_) { af[s_] = *(const bf16x8*)(_ap + s_ * 32); \
            _Pragma("unroll") for (int n_ = 0; n_ < 4; ++n_) bf[s_][n_] = *(const bf16x8*)(_bp + (size_t)n_ * 16 * K + s_ * 32); } } while (0)
    if (u < nunits) T_LOAD(u, 0);
    E.prep(64, 0, lds);
    LBAR();
    if (u >= nunits) return;
    int c = 0;
    f32x4 acc[4];
#pragma unroll
    for (int n = 0; n < 4; ++n) acc[n] = (f32x4){0.f, 0.f, 0.f, 0.f};
    for (;;) {
        bf16x8 caf[4], cbf[4][4];
#pragma unroll
        for (int s_ = 0; s_ < 4; ++s_) { caf[s_] = af[s_];
#pragma unroll
            for (int n_ = 0; n_ < 4; ++n_) cbf[s_][n_] = bf[s_][n_]; }
        const bool lastc = (c + 1 == nch); const int un = lastc ? u + G : u, cn = lastc ? 0 : c + 1; const bool more = un < nunits;
        ColInfo cie; cie.a = (f32x4){0.f, 0.f, 0.f, 0.f}; cie.b = cie.a; f32x4 pve = (f32x4){0.f, 0.f, 0.f, 0.f};
        if (lastc && tid < 256) { const int ecol = (u >> 2) * 64 + (tid & 15) * 4; cie = E.colinfo(ecol); pve = E.preload(trow((u & 3) * 16 + (tid >> 4)), ecol); }
        if (more) T_LOAD(un, cn);
#pragma unroll
        for (int s_ = 0; s_ < 4; ++s_)
#pragma unroll
            for (int n_ = 0; n_ < 4; ++n_) acc[n_] = MFMA16(cbf[s_][n_], caf[s_], acc[n_]);
        if (lastc) {
            const int rb = u & 3, cb = u >> 2;
#pragma unroll
            for (int n = 0; n < 4; ++n) { *(LAS f32x4*)(red + (wid * 16 + fr) * 68 + n * 16 + fq * 4) = acc[n]; acc[n] = (f32x4){0.f, 0.f, 0.f, 0.f}; }
            LBAR();
            if (tid < 256) {
                const int r = tid >> 4, c4 = (tid & 15) * 4; f32x4 v = (f32x4){0.f, 0.f, 0.f, 0.f};
#pragma unroll
                for (int w = 0; w < 8; ++w) v += *(const LAS f32x4*)(red + (w * 16 + r) * 68 + c4);
                const int lrow = rb * 16 + r, row = trow(lrow); const RowInfo ri = E.rowinfo(row, lrow, 0, lds);
                float s1 = 0.f, s2 = 0.f; E.apply(ri, cie, row, cb * 64 + c4, v, pve, s1, s2);
                if (Epi::STATS) {
#pragma unroll
                    for (int o = 1; o < 16; o <<= 1) { s1 += __shfl_xor(s1, o); s2 += __shfl_xor(s2, o); }
                    if ((tid & 15) == 0) *(f32x2*)(E.stat_out + ((size_t)row * 16 + cb) * 2) = (f32x2){s1, s2};
                }
            }
            LBAR();
        }
        if (!more) break;
        u = un; c = cn;
    }
#undef T_LOAD
}
template <class Epi>
__device__ __forceinline__ void gemm_tail16(LAS unsigned char* lds, const bf16_t* Ag, const bf16_t* Btg, const int K, const Epi& E) {
    const int tid = tidx(), wid = tid >> 6, lane = tid & 63, fr = lane & 15, fq = lane >> 4;
    LAS float* red = (LAS float*)lds;
    const int ks = K / 8, nch = ks / 128;
    bool first = true;
    for (int u = blockIdx.x; u < 256; u += gridDim.x) {
        const int rb = u & 3, cb = u >> 2;
        ColInfo cie; cie.a = (f32x4){0.f, 0.f, 0.f, 0.f}; cie.b = cie.a; f32x4 pve = (f32x4){0.f, 0.f, 0.f, 0.f};
        if (tid < 64) { const int ecol = cb * 16 + (tid & 3) * 4; cie = E.colinfo(ecol); pve = E.preload(trow(rb * 16 + (tid >> 2)), ecol); }
        const bf16_t* ap = Ag + (size_t)trow(rb * 16 + fr) * K + wid * ks + fq * 8;
        const bf16_t* bp = Btg + (size_t)(cb * 16 + fr) * K + wid * ks + fq * 8;
        bf16x8 af[4], bf[4];
#pragma unroll
        for (int s_ = 0; s_ < 4; ++s_) { af[s_] = *(const bf16x8*)(ap + s_ * 32); bf[s_] = *(const bf16x8*)(bp + s_ * 32); }
        if (first) { E.prep(64, 0, lds); first = false; }
        f32x4 acc = (f32x4){0.f, 0.f, 0.f, 0.f};
        for (int c = 0; c < nch; ++c) {
            bf16x8 ca[4], cbf[4];
#pragma unroll
            for (int s_ = 0; s_ < 4; ++s_) { ca[s_] = af[s_]; cbf[s_] = bf[s_]; }
            if (c + 1 < nch) {
#pragma unroll
                for (int s_ = 0; s_ < 4; ++s_) { af[s_] = *(const bf16x8*)(ap + (c + 1) * 128 + s_ * 32); bf[s_] = *(const bf16x8*)(bp + (c + 1) * 128 + s_ * 32); } }
#pragma unroll
            for (int s_ = 0; s_ < 4; ++s_) acc = MFMA16(cbf[s_], ca[s_], acc);
        }
        *(LAS f32x4*)(red + (wid * 16 + fr) * 20 + fq * 4) = acc;
        LBAR();
        if (tid < 64) {
            const int r = tid >> 2, c4 = (tid & 3) * 4; f32x4 v = (f32x4){0.f, 0.f, 0.f, 0.f};
#pragma unroll
            for (int w = 0; w < 8; ++w) v += *(const LAS f32x4*)(red + (w * 16 + r) * 20 + c4);
            const int lrow = rb * 16 + r, row = trow(lrow); const RowInfo ri = E.rowinfo(row, lrow, 0, lds);
            float s1 = 0.f, s2 = 0.f; E.apply(ri, cie, row, cb * 16 + c4, v, pve, s1, s2);
            s1 += __shfl_xor(s1, 1); s1 += __shfl_xor(s1, 2); s2 += __shfl_xor(s2, 1); s2 += __shfl_xor(s2, 2);
            if ((tid & 3) == 0) { float* sp = E.stat_out + ((size_t)row * 16 + (cb >> 2)) * 2; atomicAdd(sp, s1); atomicAdd(sp + 1, s2); }
        }
        LBAR();
    }
}
__device__ __forceinline__ void zero_tail_stats(float* stat) {
    if (blockIdx.x == 0) for (int i = tidx(); i < 64 * 32; i += NTHR) stat[(size_t)trow(i >> 5) * 32 + (i & 31)] = 0.f;
}
__device__ __forceinline__ void dt_units(LAS unsigned char* lds, const bf16_t* xb, const bf16_t* WinT, const float* stat, const float* c1, const float* c2, float* dtbuf, int fold, bf16_t* proj, const int ufirst, const int ustride) {
    const int tid = tidx(), wid = tid >> 6, lane = tid & 63, fr = lane & 15, fq = lane >> 4, rb4 = wid & 3, kh = wid >> 2;
    LAS float* red = (LAS float*)lds;
    for (int u = ufirst; u < NCHT; u += ustride) {
        if (u % NCHB == 0) {
            for (int i = tid; i < PADR * (NPROJ / 8); i += NTHR) { const int r = i / (NPROJ / 8), c8 = (i - r * (NPROJ / 8)) * 8; *(u32x4*)(proj + ((size_t)u * 64 + r) * NPROJ + c8) = (u32x4){0u, 0u, 0u, 0u}; }
        }
        const bf16_t* ap = xb + (size_t)(u * 64 + rb4 * 16 + fr) * 1024 + kh * 512 + fq * 8;
        const bf16_t* bp = WinT + (size_t)(NPROJ + fr) * 1024 + kh * 512 + fq * 8;
        f32x4 acc = (f32x4){0.f, 0.f, 0.f, 0.f};
        { bf16x8 af[16], bf[16];
#pragma unroll
            for (int s = 0; s < 16; ++s) { af[s] = *(const bf16x8*)(ap + s * 32); bf[s] = *(const bf16x8*)(bp + s * 32); }
#pragma unroll
            for (int s = 0; s < 16; ++s) acc = MFMA16(bf[s], af[s], acc);
        }
        *(LAS f32x4*)(red + (kh * 64 + rb4 * 16 + fr) * 20 + fq * 4) = acc;
        LBAR();
        if (tid < 128) {
            const int r = tid >> 1, c4 = (tid & 1) * 4; const int row = u * 64 + r;
            f32x4 v = *(const LAS f32x4*)(red + r * 20 + c4) + *(const LAS f32x4*)(red + (64 + r) * 20 + c4);
            if (fold) {
                const f32x4* sp = (const f32x4*)(stat + (size_t)row * 32); float s1 = 0.f, s2 = 0.f;
#pragma unroll
                for (int q = 0; q < 8; ++q) { const f32x4 t = sp[q]; s1 += t[0] + t[2]; s2 += t[1] + t[3]; }
                const float mu = s1 * (1.0f / 1024.0f), var = fmaxf(s2 * (1.0f / 1024.0f) - mu * mu, 0.f), rstd = __builtin_amdgcn_rsqf(var + LN_EPS);
                const f32x4 k1 = *(const f32x4*)(c1 + NPROJ + c4), k2 = *(const f32x4*)(c2 + NPROJ + c4); v = (v - k1 * mu) * rstd + k2;
            }
            if ((row % LP) < PADR) v = (f32x4){-1e30f, -1e30f, -1e30f, -1e30f};
            if (c4 == 0) *(f32x4*)(dtbuf + (size_t)row * 8) = v; else *(f32x2*)(dtbuf + (size_t)row * 8 + 4) = (f32x2){v[0], v[1]};
        }
        LBAR();
    }
}

typedef unsigned short u16x4_t __attribute__((ext_vector_type(4)));
__device__ __forceinline__ bf16x8 tr_frag(unsigned a0, unsigned a1) {
    u16x4_t x, y;
    asm volatile("ds_read_b64_tr_b16 %0, %2\n\tds_read_b64_tr_b16 %1, %3\n\ts_waitcnt lgkmcnt(0)" : "=&v"(x), "=&v"(y) : "v"(a0), "v"(a1) : "memory");
    bf16x8 r; r[0] = (short)x[0]; r[1] = (short)x[1]; r[2] = (short)x[2]; r[3] = (short)x[3]; r[4] = (short)y[0]; r[5] = (short)y[1]; r[6] = (short)y[2]; r[7] = (short)y[3];
    return r;
}
__device__ __forceinline__ void hgrn_gates(const float* z, const float* lb, float* lf, float* kk) {
#pragma unroll
    for (int j = 0; j < 8; ++j) { const float sp = __builtin_amdgcn_rcpf(1.0f + __expf(-z[j])), sn = 1.0f - sp; const float f = lb[j] + (1.0f - lb[j]) * sp; lf[j] = __builtin_amdgcn_logf(f); kk[j] = (1.0f - lb[j]) * sn; }
}
__device__ __forceinline__ void cumsum64(LAS float* Gf, LAS float* seg) {
    const int tid = tidx(), k = tid & 63, sg = tid >> 6;
    float run = 0.f;
#pragma unroll
    for (int r = 0; r < 8; ++r) { run += Gf[(sg * 8 + r) * 65 + k]; Gf[(sg * 8 + r) * 65 + k] = run; }
    seg[sg * 64 + k] = run;
    LBAR();
    float pre = 0.f;
    for (int s = 0; s < sg; ++s) pre += seg[s * 64 + k];
#pragma unroll
    for (int r = 0; r < 8; ++r) Gf[(sg * 8 + r) * 65 + k] += pre;
    LBAR();
}

struct HgRaw { u32x4 q, f, i; f32x4 lb0, lb1; };
template <int WHICH>
__device__ __forceinline__ HgRaw hg_load(KP& P_, int l, int u, int tid) {
    const bf16_t* proj = (const bf16_t*)(p.ws + WS_PROJ);
    const int idx = u - 780, bc = idx / 6, h = idx - bc * 6, t = tid >> 3, k0 = (tid & 7) * 8; const size_t row = (size_t)bc * 64 + t;
    HgRaw r; r.q = (u32x4){0u, 0u, 0u, 0u};
    if (WHICH) r.q = *(const u32x4*)(proj + row * NPROJ + h * 64 + k0);
    r.f = *(const u32x4*)(proj + row * NPROJ + C_F + h * 64 + k0);
    r.i = *(const u32x4*)(proj + row * NPROJ + C_I + h * 64 + k0);
    const float* lbv = (const float*)(p.ws + TBL(T_LB, l)) + h * 64 + k0; r.lb0 = *(const f32x4*)lbv; r.lb1 = *(const f32x4*)(lbv + 4);
    return r;
}
__device__ __forceinline__ void hgrn_a_unit(LAS unsigned char* lds, KP& P_, int l, int bc, int h, const HgRaw& in) {
    LAS float* Gf = (LAS float*)lds; LAS float* seg = (LAS float*)(lds + 16640);
    LAS bf16_t* KT = (LAS bf16_t*)(lds + 18688); LAS bf16_t* VT = (LAS bf16_t*)(lds + 27904);
    const bf16_t* proj = (const bf16_t*)(p.ws + WS_PROJ); const float* lbv = (const float*)(p.ws + TBL(T_LB, l));
    const int tid = tidx(), t = tid >> 3, k0 = (tid & 7) * 8; const size_t row = (size_t)bc * 64 + t;
    float z[8], iv[8], lf[8], kk[8], lb[8];
    unpack8(in.f, z);
    const u32x4 iraw = in.i;
#pragma unroll
    for (int j = 0; j < 4; ++j) { lb[j] = in.lb0[j]; lb[4 + j] = in.lb1[j]; }
    hgrn_gates(z, lb, lf, kk);
    {
#pragma unroll
      for (int j = 0; j < 8; ++j) Gf[t * 65 + k0 + j] = lf[j];
      *(LAS u32x4*)(VT + t * 72 + k0) = iraw; }
    (void)iv;
    LBAR();
    cumsum64(Gf, seg);
    { float kd[8];
#pragma unroll
      for (int j = 0; j < 8; ++j) { const float G = Gf[t * 65 + k0 + j], Gl = Gf[63 * 65 + k0 + j]; kd[j] = kk[j] * __builtin_amdgcn_exp2f(Gl - G); }
      if (t == 63) { f32x4 d0, d1;
#pragma unroll
          for (int j = 0; j < 4; ++j) { d0[j] = __builtin_amdgcn_exp2f(Gf[63 * 65 + k0 + j]); d1[j] = __builtin_amdgcn_exp2f(Gf[63 * 65 + k0 + 4 + j]); }
          float* dp = (float*)(p.ws + WS_DECH) + ((size_t)bc * 6 + h) * 64 + k0; *(f32x4*)dp = d0; *(f32x4*)(dp + 4) = d1; }
      *(LAS u32x4*)(KT + t * 72 + k0) = pack8(kd); }
    LBAR();
    { const int wid = tid >> 6, lane = tid & 63, fr = lane & 15, fq = lane >> 4, kt = wid >> 1;
      bf16_t* sth = (bf16_t*)(p.ws + WS_STH) + ((size_t)bc * 6 + h) * 4096;
#pragma unroll
      for (int q = 0; q < 2; ++q) { const int vt = (wid & 1) * 2 + q; f32x4 acc = (f32x4){0.f, 0.f, 0.f, 0.f};
#pragma unroll
          for (int ks = 0; ks < 2; ++ks) { const unsigned ro = (unsigned)((32 * ks + 8 * fq + (fr >> 2)) * 144 + 8 * (fr & 3));
              const unsigned ka = (unsigned)(size_t)KT + ro + 32u * kt, va = (unsigned)(size_t)VT + ro + 32u * vt;
              const bf16x8 a = tr_frag(ka, ka + 576u), b = tr_frag(va, va + 576u); acc = MFMA16(a, b, acc); }
          *(u32x2*)(sth + (size_t)(vt * 16 + fr) * 64 + kt * 16 + fq * 4) = pack4(acc); } }
    LBAR();
}

__device__ __forceinline__ void hgrn_c_unit(LAS unsigned char* lds, KP& P_, int l, int bc, int h, const HgRaw& in) {
    LAS float* Gf = (LAS float*)lds; LAS float* seg = (LAS float*)(lds + 16640);
    LAS bf16_t* QP = (LAS bf16_t*)(lds + 18688); LAS bf16_t* QPP = (LAS bf16_t*)(lds + 27904); LAS bf16_t* KP = (LAS bf16_t*)(lds + 37120);
    LAS bf16_t* VT = (LAS bf16_t*)(lds + 46336); LAS bf16_t* PM = (LAS bf16_t*)(lds + 55552); LAS float* ss = (LAS float*)(lds + 64768);
    const bf16_t* proj = (const bf16_t*)(p.ws + WS_PROJ); const float* lbv = (const float*)(p.ws + TBL(T_LB, l));
    const int tid = tidx(), t = tid >> 3, k0 = (tid & 7) * 8; const size_t row = (size_t)bc * 64 + t;
    const int wid = tid >> 6, lane = tid & 63, fr = lane & 15, fq = lane >> 4;
    float z[8], q[8], lf[8], kk[8], lb[8];
    const int tt2 = wid & 3, vh = wid >> 2;
    bf16x8 sf[2][2]; u32x2 graw[2];
    { const bf16_t* sth = (const bf16_t*)(p.ws + WS_STH) + ((size_t)bc * 6 + h) * 4096;
#pragma unroll
      for (int qq = 0; qq < 2; ++qq) { const int vt = vh * 2 + qq;
#pragma unroll
          for (int ks = 0; ks < 2; ++ks) sf[qq][ks] = *(const bf16x8*)(sth + (size_t)(vt * 16 + fr) * 64 + ks * 32 + fq * 8);
          graw[qq] = *(const u32x2*)(proj + ((size_t)bc * 64 + tt2 * 16 + fr) * NPROJ + C_G + h * 64 + vt * 16 + fq * 4); } }
    f32x4 nwv[2];
#pragma unroll
    for (int qq = 0; qq < 2; ++qq) nwv[qq] = *(const f32x4*)(p.in[4] + l * 64 + (vh * 2 + qq) * 16 + fq * 4);
    unpack8(in.q, q);
    unpack8(in.f, z);
    const u32x4 iraw = in.i;
#pragma unroll
    for (int j = 0; j < 8; ++j) { lb[j] = j < 4 ? in.lb0[j & 3] : in.lb1[j & 3]; q[j] = siluf_(q[j]); }
    hgrn_gates(z, lb, lf, kk);
    {
#pragma unroll
      for (int j = 0; j < 8; ++j) Gf[t * 65 + k0 + j] = lf[j];
      *(LAS u32x4*)(VT + t * 72 + k0) = iraw; }
    LBAR();
    cumsum64(Gf, seg);
    { float a[8], b[8], c[8];
#pragma unroll
      for (int j = 0; j < 8; ++j) { const float G = Gf[t * 65 + k0 + j], R = Gf[31 * 65 + k0 + j]; a[j] = q[j] * __builtin_amdgcn_exp2f(G - R); b[j] = q[j] * __builtin_amdgcn_exp2f(G); c[j] = kk[j] * __builtin_amdgcn_exp2f(R - G); }
      *(LAS u32x4*)(QP + t * 72 + k0) = pack8(a); *(LAS u32x4*)(QPP + t * 72 + k0) = pack8(b); *(LAS u32x4*)(KP + t * 72 + k0) = pack8(c); }
    LBAR();
    {
        const int tt = wid >> 1;
#pragma unroll
        for (int qq = 0; qq < 2; ++qq) { const int st = (wid & 1) * 2 + qq; f32x4 acc = (f32x4){0.f, 0.f, 0.f, 0.f};
            if (st <= tt) {
#pragma unroll
                for (int ks = 0; ks < 2; ++ks) { const bf16x8 a = *(const LAS bf16x8*)(KP + (st * 16 + fr) * 72 + ks * 32 + fq * 8), b = *(const LAS bf16x8*)(QP + (tt * 16 + fr) * 72 + ks * 32 + fq * 8); acc = MFMA16(a, b, acc); }
                const int tq = tt * 16 + fr;
#pragma unroll
                for (int j = 0; j < 4; ++j) if (st * 16 + fq * 4 + j > tq) acc[j] = 0.f;
            }
            *(LAS u32x2*)(PM + (tt * 16 + fr) * 72 + st * 16 + fq * 4) = pack4(acc); }
    }
    LBAR();
    const int tt = tt2;
    f32x4 o[2];
    { float ssq = 0.f;
#pragma unroll
      for (int qq = 0; qq < 2; ++qq) { const int vt = vh * 2 + qq; f32x4 acc = (f32x4){0.f, 0.f, 0.f, 0.f};
#pragma unroll
          for (int ks = 0; ks < 2; ++ks) { const unsigned va = (unsigned)(size_t)VT + (unsigned)((32 * ks + 8 * fq + (fr >> 2)) * 144 + 8 * (fr & 3)) + 32u * vt;
              const bf16x8 a = tr_frag(va, va + 576u), b = *(const LAS bf16x8*)(PM + (tt * 16 + fr) * 72 + ks * 32 + fq * 8); acc = MFMA16(a, b, acc); }
#pragma unroll
          for (int ks = 0; ks < 2; ++ks) { const bf16x8 b = *(const LAS bf16x8*)(QPP + (tt * 16 + fr) * 72 + ks * 32 + fq * 8); acc = MFMA16(sf[qq][ks], b, acc); }
          o[qq] = acc; ssq += (acc[0] * acc[0] + acc[1] * acc[1]) + (acc[2] * acc[2] + acc[3] * acc[3]); }
      ssq += __shfl_xor(ssq, 16); ssq += __shfl_xor(ssq, 32);
      if (fq == 0) ss[(tt * 16 + fr) * 2 + vh] = ssq; }
    LBAR();
    { const int tq = tt * 16 + fr; const float rinv = __builtin_amdgcn_rsqf((ss[tq * 2] + ss[tq * 2 + 1]) * (1.0f / 64.0f) + RMS_EPS);
      const size_t orow = (size_t)bc * 64 + tq; bf16_t* mixed = (bf16_t*)(p.ws + WS_MIXED); const float* nw = p.in[4] + l * 64;
#pragma unroll
      for (int qq = 0; qq < 2; ++qq) { const int v = (vh * 2 + qq) * 16 + fq * 4;
          const float gv[4] = {bflo(graw[qq].x), bfhi(graw[qq].x), bflo(graw[qq].y), bfhi(graw[qq].y)}; f32x4 r;
#pragma unroll
          for (int j = 0; j < 4; ++j) r[j] = o[qq][j] * rinv * nwv[qq][j] * siluf_(gv[j]);
          *(u32x2*)(mixed + orow * DM + h * 64 + v) = pack4(r); } }
    LBAR();
}

__device__ __forceinline__ void m2_dt(KP& P_, int l, int bc, int grp, LAS float* dtl, LAS float* acs, LAS float* wl, bool write_dec) {
    const int tid = tidx(), wid = tid >> 6, lane = tid & 63;
    if (wid < 3) {
        const int head = grp * 3 + wid; const float draw = ((const float*)(p.ws + WS_DT))[((size_t)bc * 64 + lane) * 8 + head];
        const float dt = draw < -1e29f ? 0.f : softplusf_(draw + p.in[7][l * 6 + head]);
        const float a = -expf(p.in[8][l * 6 + head]); float x = dt * a;
#pragma unroll
        for (int off = 1; off < 64; off <<= 1) { const float v = __shfl_up(x, off); if (lane >= off) x += v; }
        const float tot = __shfl(x, 63);
        dtl[wid * 64 + lane] = dt; acs[wid * 64 + lane] = x; wl[wid * 64 + lane] = dt * __expf(tot - x);
        if (write_dec && lane == 63) ((float*)(p.ws + WS_DECM))[(size_t)bc * 6 + head] = __expf(tot);
    }
}
__device__ __forceinline__ void m2_load_cw(LAS float* CW, KP& P_, int l, int grp, int nch) {
    const float* cw = p.in[5] + (size_t)l * 4 * 896; const float* cb = p.in[6] + (size_t)l * 896;
    float v[5]; const int t0 = tidx();
#pragma unroll
    for (int q = 0; q < 5; ++q) { const int i = t0 + q * NTHR; v[q] = 0.f;
        if (i < 5 * nch) { const int tap = i / nch, c = i - tap * nch;
            const int gch = c < 192 ? grp * 192 + c : (c < 320 ? 384 + grp * 128 + (c - 192) : 640 + grp * 128 + (c - 320));
            v[q] = tap < 4 ? cw[tap * 896 + gch] : cb[gch]; } }
#pragma unroll
    for (int q = 0; q < 5; ++q) { const int i = t0 + q * NTHR; if (i < 5 * nch) { const int tap = i / nch, c = i - tap * nch; CW[tap * 448 + c] = v[q]; } }
}
__device__ __forceinline__ int m2_pcol(int grp, int cgi) { return cgi < 24 ? C_X + grp * 192 + cgi * 8 : (cgi < 40 ? C_B + grp * 128 + (cgi - 24) * 8 : C_C + grp * 128 + (cgi - 40) * 8); }
__device__ __forceinline__ void m2_conv_load(KP& P_, int bc, int t, int pcol, u32x4* raw) {
    const bf16_t* proj = (const bf16_t*)(p.ws + WS_PROJ);
#pragma unroll
    for (int tap = 0; tap < 4; ++tap) { const int gr = max(bc * 64 + t - 3 + tap, 0); raw[tap] = *(const u32x4*)(proj + (size_t)gr * NPROJ + pcol); }
}
__device__ __forceinline__ void m2_conv_compute(const LAS float* CW, int c0, const u32x4* raw, float* y) {
    { const f32x4 b0 = *(const LAS f32x4*)(CW + 4 * 448 + c0), b1 = *(const LAS f32x4*)(CW + 4 * 448 + c0 + 4);
#pragma unroll
      for (int j = 0; j < 4; ++j) { y[j] = b0[j]; y[4 + j] = b1[j]; } }
#pragma unroll
    for (int tap = 0; tap < 4; ++tap) { float x[8]; unpack8(raw[tap], x); const f32x4 w0 = *(const LAS f32x4*)(CW + tap * 448 + c0), w1 = *(const LAS f32x4*)(CW + tap * 448 + c0 + 4);
#pragma unroll
        for (int j = 0; j < 4; ++j) { y[j] += w0[j] * x[j]; y[4 + j] += w1[j] * x[4 + j]; } }
#pragma unroll
    for (int j = 0; j < 8; ++j) y[j] = siluf_(y[j]);
}

__device__ void m2_a_unit(LAS unsigned char* lds, KP& P_, int l, int bc, int grp) {
    LAS bf16_t* XN = (LAS bf16_t*)lds;
    LAS bf16_t* BN = (LAS bf16_t*)(lds + 27648);
    LAS float* dtl = (LAS float*)(lds + 46080); LAS float* acs = (LAS float*)(lds + 46848); LAS float* wl = (LAS float*)(lds + 47616); LAS float* CW = (LAS float*)(lds + 48384);
    const int tid = tidx(), wid = tid >> 6, lane = tid & 63, fr = lane & 15, fq = lane >> 4;
    u32x4 raw[5][4];
    { int t = tid / 40, cgi = tid - t * 40;
#pragma unroll
      for (int it = 0; it < 5; ++it) { m2_conv_load(P_, bc, t, m2_pcol(grp, cgi), raw[it]); t += 12; cgi += 32; if (cgi >= 40) { cgi -= 40; ++t; } } }
    m2_dt(P_, l, bc, grp, dtl, acs, wl, true);
    m2_load_cw(CW, P_, l, grp, 320);
    LBAR();
    int t = tid / 40, cgi = tid - (tid / 40) * 40;
#pragma unroll
    for (int it = 0; it < 5; ++it) { float y[8];
        m2_conv_compute(CW, cgi * 8, raw[it], y);
        if (cgi < 24) { const float w = wl[(cgi >> 3) * 64 + t];
#pragma unroll
            for (int j = 0; j < 8; ++j) y[j] *= w;
            *(LAS u32x4*)(XN + t * 200 + cgi * 8) = pack8(y); }
        else *(LAS u32x4*)(BN + t * 136 + (cgi - 24) * 8) = pack8(y);
        t += 12; cgi += 32; if (cgi >= 40) { cgi -= 40; ++t; } }
    LBAR();
    { const int nt = wid; bf16x8 a[2];
      const unsigned xn_base = (unsigned)(size_t)XN, bn_base = (unsigned)(size_t)BN;
#pragma unroll
      for (int ks = 0; ks < 2; ++ks) { const unsigned ba = bn_base + (unsigned)((32 * ks + 8 * fq + (fr >> 2)) * 272 + 8 * (fr & 3)) + 32u * nt; a[ks] = tr_frag(ba, ba + 1088u); }
      bf16_t* stm = (bf16_t*)(p.ws + WS_STM);
      for (int pt = 0; pt < 12; ++pt) { f32x4 acc = (f32x4){0.f, 0.f, 0.f, 0.f};
#pragma unroll
          for (int ks = 0; ks < 2; ++ks) { const unsigned xa = xn_base + (unsigned)((32 * ks + 8 * fq + (fr >> 2)) * 400 + 8 * (fr & 3)) + 32u * pt; const bf16x8 b = tr_frag(xa, xa + 1600u); acc = MFMA16(a[ks], b, acc); }
          const int head = grp * 3 + (pt >> 2), pl = (pt & 3) * 16 + fr;
          *(u32x2*)(stm + (((size_t)bc * 6 + head) * 64 + pl) * 128 + nt * 16 + fq * 4) = pack4(acc); } }
    LBAR();
}

__device__ void m2_c_unit(LAS unsigned char* lds, KP& P_, int l, int bc, int grp) {
    LAS bf16_t* XN = (LAS bf16_t*)lds;
    LAS bf16_t* BM = (LAS bf16_t*)(lds + 27648); LAS bf16_t* CM = (LAS bf16_t*)(lds + 45056); LAS bf16_t* PH = (LAS bf16_t*)(lds + 62464);
    LAS float* dtl = (LAS float*)(lds + 90112); LAS float* acs = (LAS float*)(lds + 90880); LAS float* wl = (LAS float*)(lds + 91648); LAS float* ss = (LAS float*)(lds + 92416);
    LAS float* CW = (LAS float*)(lds + 92928);
    const bf16_t* proj = (const bf16_t*)(p.ws + WS_PROJ);
    const int tid = tidx(), wid = tid >> 6, lane = tid & 63, fr = lane & 15, fq = lane >> 4;
    {
        u32x4 raw[7][4];
        { int t = tid / 56, cgi = tid - t * 56;
#pragma unroll
          for (int it = 0; it < 7; ++it) { m2_conv_load(P_, bc, t, m2_pcol(grp, cgi), raw[it]); t += 9; cgi += 8; if (cgi >= 56) { cgi -= 56; ++t; } } }
        m2_dt(P_, l, bc, grp, dtl, acs, wl, false);
        m2_load_cw(CW, P_, l, grp, 448);
        LBAR();
        int t = tid / 56, cgi = tid - (tid / 56) * 56;
#pragma unroll
        for (int it = 0; it < 7; ++it) { float y[8];
            m2_conv_compute(CW, cgi * 8, raw[it], y);
            if (cgi < 24) *(LAS u32x4*)(XN + t * 200 + cgi * 8) = pack8(y);
            else if (cgi < 40) *(LAS u32x4*)(BM + t * 136 + (cgi - 24) * 8) = pack8(y);
            else *(LAS u32x4*)(CM + t * 136 + (cgi - 40) * 8) = pack8(y);
            t += 9; cgi += 8; if (cgi >= 56) { cgi -= 56; ++t; } }
    }
    LBAR();
    {
        const int tt = wid >> 1;
#pragma unroll
        for (int qq = 0; qq < 2; ++qq) { const int st = (wid & 1) * 2 + qq; f32x4 acc = (f32x4){0.f, 0.f, 0.f, 0.f};
            if (st <= tt) {
#pragma unroll
                for (int ks = 0; ks < 4; ++ks) { const bf16x8 a = *(const LAS bf16x8*)(BM + (st * 16 + fr) * 136 + ks * 32 + fq * 8), b = *(const LAS bf16x8*)(CM + (tt * 16 + fr) * 136 + ks * 32 + fq * 8); acc = MFMA16(a, b, acc); } }
            const int tq = tt * 16 + fr;
#pragma unroll
            for (int hh = 0; hh < 3; ++hh) { f32x4 r; const float at = acs[hh * 64 + tq];
#pragma unroll
                for (int j = 0; j < 4; ++j) { const int s = st * 16 + fq * 4 + j; r[j] = (s <= tq) ? acc[j] * __expf(at - acs[hh * 64 + s]) * dtl[hh * 64 + s] : 0.f; }
                *(LAS u32x2*)(PH + hh * 4608 + tq * 72 + st * 16 + fq * 4) = pack4(r); } }
    }
    LBAR();
    const int tt = wid & 3, ph = wid >> 2, tq = tt * 16 + fr; const size_t orow = (size_t)bc * 64 + tq;
    const unsigned xn_base = (unsigned)(size_t)XN;
    f32x4 yv[6], nwv[6];
#pragma unroll
    for (int i = 0; i < 6; ++i) nwv[i] = *(const f32x4*)(p.in[10] + l * 384 + grp * 192 + (ph * 6 + i) * 16 + fq * 4);
    { bf16x8 cf[4];
#pragma unroll
      for (int ks = 0; ks < 4; ++ks) cf[ks] = *(const LAS bf16x8*)(CM + tq * 136 + ks * 32 + fq * 8);
      const bf16_t* stm = (const bf16_t*)(p.ws + WS_STM); float ssq = 0.f;
      u32x2 zraw[6];
#pragma unroll
      for (int i = 0; i < 6; ++i) zraw[i] = *(const u32x2*)(proj + orow * NPROJ + C_Z + grp * 192 + (ph * 6 + i) * 16 + fq * 4);
      bf16x8 hf[4];
#pragma unroll
      for (int ks = 0; ks < 4; ++ks) hf[ks] = *(const bf16x8*)(stm + (((size_t)bc * 6 + grp * 3 + ((ph * 6) >> 2)) * 64 + ((ph * 6) & 3) * 16 + fr) * 128 + ks * 32 + fq * 8);
#pragma unroll
      for (int i = 0; i < 6; ++i) { const int pt = ph * 6 + i, hh = pt >> 2, head = grp * 3 + hh;
          f32x4 ad = (f32x4){0.f, 0.f, 0.f, 0.f}, ao = (f32x4){0.f, 0.f, 0.f, 0.f};
          bf16x8 hc[4];
#pragma unroll
          for (int ks = 0; ks < 4; ++ks) hc[ks] = hf[ks];
          if (i < 5) { const int pn = pt + 1;
#pragma unroll
              for (int ks = 0; ks < 4; ++ks) hf[ks] = *(const bf16x8*)(stm + (((size_t)bc * 6 + grp * 3 + (pn >> 2)) * 64 + (pn & 3) * 16 + fr) * 128 + ks * 32 + fq * 8); }
#pragma unroll
          for (int ks = 0; ks < 2; ++ks) { const unsigned ta = xn_base + (unsigned)((32 * ks + 8 * fq + (fr >> 2)) * 400 + (16 * pt + 4 * (fr & 3)) * 2);
              const bf16x8 a = tr_frag(ta, ta + 1600u), b = *(const LAS bf16x8*)(PH + hh * 4608 + tq * 72 + ks * 32 + fq * 8); ad = MFMA16(a, b, ad); }
#pragma unroll
          for (int ks = 0; ks < 4; ++ks) ao = MFMA16(hc[ks], cf[ks], ao);
          const float ea = __expf(acs[hh * 64 + tq]), dsk = p.in[9][l * 6 + head]; const int pch = pt * 16 + fq * 4;
          const float zv[4] = {bflo(zraw[i].x), bfhi(zraw[i].x), bflo(zraw[i].y), bfhi(zraw[i].y)};
          f32x4 y;
          const u32x2 xraw = *(const LAS u32x2*)(XN + tq * 200 + pch); const float xsv[4] = {bflo(xraw.x), bfhi(xraw.x), bflo(xraw.y), bfhi(xraw.y)};
#pragma unroll
          for (int j = 0; j < 4; ++j) { y[j] = (ad[j] + ea * ao[j] + dsk * xsv[j]) * siluf_(zv[j]); ssq += y[j] * y[j]; }
          yv[i] = y; }
      ssq += __shfl_xor(ssq, 16); ssq += __shfl_xor(ssq, 32);
      if (fq == 0) ss[tq * 2 + ph] = ssq; }
    LBAR();
    { const float rinv = __builtin_amdgcn_rsqf((ss[tq * 2] + ss[tq * 2 + 1]) * (1.0f / 192.0f) + RMS_EPS);
      bf16_t* mixed = (bf16_t*)(p.ws + WS_MIXED); const float* nw = p.in[10] + l * 384 + grp * 192;
#pragma unroll
      for (int i = 0; i < 6; ++i) { const int pch = (ph * 6 + i) * 16 + fq * 4; f32x4 r;
#pragma unroll
          for (int j = 0; j < 4; ++j) r[j] = yv[i][j] * rinv * nwv[i][j];
          *(u32x2*)(mixed + orow * DM + 384 + grp * 192 + pch) = pack4(r); } }
    LBAR();
}

__device__ __forceinline__ void s5_bu_block(const LAS bf16_t* UB, LAS bf16_t* XW, const bf16x8* bfrag, int blk, int g, int fr, int fq) {
    bf16x8 af = (bf16x8){0, 0, 0, 0, 0, 0, 0, 0};
    if (fq < 2) af = *(const LAS bf16x8*)(UB + (blk * 16 + fr) * 264 + g * 16 + fq * 8);
#pragma unroll
    for (int tile = 0; tile < 8; ++tile) { f32x4 acc = (f32x4){0.f, 0.f, 0.f, 0.f}; acc = MFMA16(bfrag[tile], af, acc);
        *(LAS u32x2*)(XW + fr * 136 + tile * 16 + fq * 4) = pack4(acc); }
    asm volatile("" ::: "memory");
}
__device__ __forceinline__ void s5_load_bfrag(KP& P_, int l, bf16x8* bfrag, int g, int fr, int fq) {
    const bf16_t* bbh = (const bf16_t*)(p.ws + TBL(T_S5BBH, l)) + (size_t)(g * 128 + fr) * 16 + (fq & 1) * 8;
#pragma unroll
    for (int tile = 0; tile < 8; ++tile) { bfrag[tile] = (bf16x8){0, 0, 0, 0, 0, 0, 0, 0}; if (fq < 2) bfrag[tile] = *(const bf16x8*)(bbh + tile * 256); }
}
__device__ __forceinline__ void s5_load_u(LAS bf16_t* UB, KP& P_, int bc) {
    const bf16_t* proj = (const bf16_t*)(p.ws + WS_PROJ);
    for (int it = 0; it < 4; ++it) { const int item = it * NTHR + tidx(), t = item >> 5, c8 = (item & 31) * 8;
        *(LAS u32x4*)(UB + t * 264 + c8) = *(const u32x4*)(proj + ((size_t)bc * 64 + t) * NPROJ + C_U + c8); }
}
__device__ void s5_a_unit(LAS unsigned char* lds, KP& P_, int l, int bc) {
    LAS bf16_t* UB = (LAS bf16_t*)lds; LAS bf16_t* XB = (LAS bf16_t*)(lds + 33792);
    const int tid = tidx(), wid = tid >> 6, lane = tid & 63, fr = lane & 15, fq = lane >> 4;
    s5_load_u(UB, P_, bc);
    LBAR();
    LAS bf16_t* XW = XB + wid * 2176;
    for (int gp = 0; gp < 2; ++gp) { const int g = gp * 8 + wid, n = lane;
        bf16x8 bfrag[8]; s5_load_bfrag(P_, l, bfrag, g, fr, fq);
        const f32x4 lam = *(const f32x4*)((const float*)(p.ws + TBL(T_S5LAM, l)) + (size_t)(g * 64 + n) * 4);
        float xr = 0.f, xi = 0.f;
        for (int blk = 0; blk < 4; ++blk) {
            s5_bu_block(UB, XW, bfrag, blk, g, fr, fq);
#pragma unroll
            for (int tl = 0; tl < 16; ++tl) { const unsigned w = *(const LAS unsigned*)(XW + tl * 136 + 2 * n);
                const float nr = lam[0] * xr - lam[1] * xi + bflo(w), ni = lam[0] * xi + lam[1] * xr + bfhi(w); xr = nr; xi = ni; }
            asm volatile("" ::: "memory");
        }
        *(f32x2*)((float*)(p.ws + WS_STS) + (((size_t)bc * 16 + g) * 64 + n) * 2) = (f32x2){xr, xi}; }
    LBAR();
}
__device__ void s5_c_unit(LAS unsigned char* lds, KP& P_, int l, int bc) {
    LAS bf16_t* UB = (LAS bf16_t*)lds; LAS bf16_t* XB = (LAS bf16_t*)(lds + 33792); LAS bf16_t* YG = (LAS bf16_t*)(lds + 68608);
    const int tid = tidx(), wid = tid >> 6, lane = tid & 63, fr = lane & 15, fq = lane >> 4;
    s5_load_u(UB, P_, bc);
    LBAR();
    LAS bf16_t* XW = XB + wid * 2176;
    for (int gp = 0; gp < 2; ++gp) { const int g = gp * 8 + wid, n = lane;
        bf16x8 bfrag[8]; s5_load_bfrag(P_, l, bfrag, g, fr, fq);
        const f32x4 lam = *(const f32x4*)((const float*)(p.ws + TBL(T_S5LAM, l)) + (size_t)(g * 64 + n) * 4);
        const f32x2 x0 = *(const f32x2*)((const float*)(p.ws + WS_STS) + (((size_t)bc * 16 + g) * 64 + n) * 2);
        float xr = x0.x, xi = x0.y;
        bf16x8 cf[4]; const bf16_t* cm = (const bf16_t*)(p.ws + TBL(T_S5C, l)) + (size_t)(g * 16 + fr) * 128;
#pragma unroll
        for (int ks = 0; ks < 4; ++ks) cf[ks] = *(const bf16x8*)(cm + ks * 32 + fq * 8);
        const float* dsk = p.in[18] + l * 256 + g * 16 + fq * 4;
        for (int blk = 0; blk < 4; ++blk) {
            s5_bu_block(UB, XW, bfrag, blk, g, fr, fq);
#pragma unroll
            for (int tl = 0; tl < 16; ++tl) { LAS unsigned* wp = (LAS unsigned*)(XW + tl * 136 + 2 * n); const unsigned w = *wp;
                const float nr = lam[0] * xr - lam[1] * xi + bflo(w), ni = lam[0] * xi + lam[1] * xr + bfhi(w); xr = nr; xi = ni; *wp = cvt_pk_bf16(xr, xi); }
            asm volatile("" ::: "memory");
            f32x4 acc = (f32x4){0.f, 0.f, 0.f, 0.f};
#pragma unroll
            for (int ks = 0; ks < 4; ++ks) { const bf16x8 b = *(const LAS bf16x8*)(XW + fr * 136 + ks * 32 + fq * 8); acc = MFMA16(cf[ks], b, acc); }
            const int t = blk * 16 + fr; const u32x2 uraw = *(const LAS u32x2*)(UB + t * 264 + g * 16 + fq * 4);
            const float uv[4] = {bflo(uraw.x), bfhi(uraw.x), bflo(uraw.y), bfhi(uraw.y)}; f32x4 y;
#pragma unroll
            for (int j = 0; j < 4; ++j) y[j] = gelu_tanh(acc[j] + dsk[j] * uv[j]);
            *(LAS u32x2*)(YG + t * 264 + g * 16 + fq * 4) = pack4(y);
            asm volatile("" ::: "memory");
        } }
    LBAR();
    {
        const int tt = wid & 3, jh = wid >> 2, tq = tt * 16 + fr; bf16x8 yf[8];
#pragma unroll
        for (int ks = 0; ks < 8; ++ks) yf[ks] = *(const LAS bf16x8*)(YG + tq * 264 + ks * 32 + fq * 8);
        const bf16_t* glut = (const bf16_t*)(p.ws + TBL(T_GLUT, l)); const float* gb = p.in[20] + l * 256; bf16_t* mixed = (bf16_t*)(p.ws + WS_MIXED);
        bf16x8 gn[8]; f32x4 gbv[8];
#pragma unroll
        for (int i = 0; i < 8; ++i) gbv[i] = *(const f32x4*)(gb + (jh * 8 + i) * 16 + fq * 4);
#pragma unroll
        for (int ks = 0; ks < 8; ++ks) gn[ks] = *(const bf16x8*)(glut + (size_t)(jh * 128 + fr) * 256 + ks * 32 + fq * 8);
#pragma unroll
        for (int i = 0; i < 8; ++i) { const int jt = jh * 8 + i; f32x4 acc = (f32x4){0.f, 0.f, 0.f, 0.f};
            bf16x8 gc[8];
#pragma unroll
            for (int ks = 0; ks < 8; ++ks) gc[ks] = gn[ks];
            if (i < 7) {
#pragma unroll
                for (int ks = 0; ks < 8; ++ks) gn[ks] = *(const bf16x8*)(glut + (size_t)((jt + 1) * 16 + fr) * 256 + ks * 32 + fq * 8); }
#pragma unroll
            for (int ks = 0; ks < 8; ++ks) acc = MFMA16(gc[ks], yf[ks], acc);
            const int jc = jt * 16 + fq * 4; const u32x2 yraw = *(const LAS u32x2*)(YG + tq * 264 + jc); const float yv[4] = {bflo(yraw.x), bfhi(yraw.x), bflo(yraw.y), bfhi(yraw.y)}; f32x4 r;
#pragma unroll
            for (int j = 0; j < 4; ++j) r[j] = yv[j] * sigmoidf_(acc[j] + gbv[i][j]);
            *(u32x2*)(mixed + ((size_t)bc * 64 + tq) * DM + 768 + jc) = pack4(r); }
    }
    LBAR();
}

constexpr int NMIXU = 260 + 520 + 1560;
constexpr size_t WS_CTR = WS_BAR + 14336;
template <int WHICH>
__device__ void phase_mix_dyn(LAS unsigned char* lds, KP& P0, int l0) {
    volatile LAS int* tick = (volatile LAS int*)(lds + LDS_BYTES - 32);
    const int tid0 = tidx();
    unsigned* ctr; { KPtr P_ = P0; ctr = (unsigned*)(p.ws + WS_CTR) + (l0 * 2 + WHICH) * 64; }
    int n1 = 0, n2 = 0;
    if (tid0 == 0) { n1 = (int)__hip_atomic_fetch_add(ctr, 1u, __ATOMIC_RELAXED, __HIP_MEMORY_SCOPE_AGENT); n2 = (int)__hip_atomic_fetch_add(ctr, 1u, __ATOMIC_RELAXED, __HIP_MEMORY_SCOPE_AGENT); }
    int u, un;
    for (;;) {
        if (tid0 == 0) { tick[0] = n1; tick[1] = n2; }
        LBAR();
        u = tick[0]; un = tick[1];
        if (u >= 780) break;
        if (tid0 == 0) { n1 = n2; n2 = (int)__hip_atomic_fetch_add(ctr, 1u, __ATOMIC_RELAXED, __HIP_MEMORY_SCOPE_AGENT); }
        KPtr P_ = P0; int l = l0; asm volatile("" : "+s"(P_.q), "+s"(l));
        if (WHICH == 0) { if (u < 520) m2_a_unit(lds, P_, l, u >> 1, u & 1); else s5_a_unit(lds, P_, l, u - 520); }
        else            { if (u < 520) m2_c_unit(lds, P_, l, u >> 1, u & 1); else s5_c_unit(lds, P_, l, u - 520); }
    }
    if (u >= NMIXU) return;
    HgRaw nxt; { KPtr P_ = P0; asm volatile("" : "+s"(P_.q)); nxt = hg_load<WHICH>(P_, l0, u, tid0); }
    for (;;) {
        if (tid0 == 0) { n1 = n2; n2 = (int)__hip_atomic_fetch_add(ctr, 1u, __ATOMIC_RELAXED, __HIP_MEMORY_SCOPE_AGENT); }
        KPtr P_ = P0; int l = l0; asm volatile("" : "+s"(P_.q), "+s"(l));
        const HgRaw cur = nxt;
        if (un < NMIXU) nxt = hg_load<WHICH>(P_, l, un, tid0);
        if (WHICH == 0) hgrn_a_unit(lds, P_, l, (u - 780) / 6, (u - 780) % 6, cur);
        else            hgrn_c_unit(lds, P_, l, (u - 780) / 6, (u - 780) % 6, cur);
        if (un >= NMIXU) break;
        if (tid0 == 0) { tick[0] = n1; tick[1] = n2; }
        LBAR();
        u = tick[0]; un = tick[1];
    }
}
__device__ void phase_mix_b(KP& P_, int l) {
    const int gt = blockIdx.x * NTHR + tidx(), GT = gridDim.x * NTHR;
    for (int e = gt; e < 24576 + 12288 + 4096; e += GT) {
        if (e < 24576) {
            const int n8 = e & 15, pp = (e >> 4) & 63, bh = e >> 10, head = bh % 6, b = bh / 6;
            bf16_t* base = (bf16_t*)(p.ws + WS_STM) + (((size_t)(b * NCHB) * 6 + head) * 64 + pp) * 128 + n8 * 8; const float* dec = (const float*)(p.ws + WS_DECM) + (size_t)(b * NCHB) * 6 + head;
            float s[8];
#pragma unroll
            for (int j = 0; j < 8; ++j) s[j] = 0.f;
            for (int cb = 0; cb < NCHB; cb += 13) { u32x4 uu[13]; float d[13];
#pragma unroll
                for (int i = 0; i < 13; ++i) { uu[i] = *(const u32x4*)(base + (size_t)(cb + i) * 6 * 8192); d[i] = dec[(cb + i) * 6]; }
#pragma unroll
                for (int i = 0; i < 13; ++i) { float uf[8]; unpack8(uu[i], uf); *(u32x4*)(base + (size_t)(cb + i) * 6 * 8192) = pack8(s);
#pragma unroll
                    for (int j = 0; j < 8; ++j) s[j] = d[i] * s[j] + uf[j]; } }
        } else if (e < 24576 + 12288) {
            const int e2 = e - 24576, k8 = e2 & 7, v = (e2 >> 3) & 63, bh = e2 >> 9, h = bh % 6, b = bh / 6;
            bf16_t* base = (bf16_t*)(p.ws + WS_STH) + (((size_t)(b * NCHB) * 6 + h) * 64 + v) * 64 + k8 * 8; const float* dec = (const float*)(p.ws + WS_DECH) + ((size_t)(b * NCHB) * 6 + h) * 64 + k8 * 8;
            float s[8];
#pragma unroll
            for (int j = 0; j < 8; ++j) s[j] = 0.f;
            for (int cb = 0; cb < NCHB; cb += 13) { u32x4 uu[13]; f32x4 d0[13], d1[13];
#pragma unroll
                for (int i = 0; i < 13; ++i) { uu[i] = *(const u32x4*)(base + (size_t)(cb + i) * 6 * 4096); const f32x4* dp = (const f32x4*)(dec + (size_t)(cb + i) * 384); d0[i] = dp[0]; d1[i] = dp[1]; }
#pragma unroll
                for (int i = 0; i < 13; ++i) { float uf[8]; unpack8(uu[i], uf); *(u32x4*)(base + (size_t)(cb + i) * 6 * 4096) = pack8(s);
#pragma unroll
                    for (int j = 0; j < 4; ++j) { s[j] = d0[i][j] * s[j] + uf[j]; s[4 + j] = d1[i][j] * s[4 + j] + uf[4 + j]; } } }
        } else {
            const int e2 = e - 24576 - 12288, gn = e2 & 1023, b = e2 >> 10;
            float* base = (float*)(p.ws + WS_STS) + ((size_t)(b * NCHB) * 1024 + gn) * 2; const f32x4 lam = *(const f32x4*)((const float*)(p.ws + TBL(T_S5LAM, l)) + (size_t)gn * 4);
            float xr = 0.f, xi = 0.f; asm volatile("" : "+v"(xr), "+v"(xi));
            for (int cb = 0; cb < NCHB; cb += 13) { f32x2 ev[13];
#pragma unroll
                for (int i = 0; i < 13; ++i) ev[i] = *(const f32x2*)(base + (size_t)(cb + i) * 2048);
#pragma unroll
                for (int i = 0; i < 13; ++i) { *(f32x2*)(base + (size_t)(cb + i) * 2048) = (f32x2){xr, xi};
                    const float nr = lam[2] * xr - lam[3] * xi + ev[i].x, ni = lam[2] * xi + lam[3] * xr + ev[i].y; xr = nr; xi = ni; } }
        }
    }
}

__device__ void phase_final(KP& P_) {
    const bf16_t* xb = (const bf16_t*)(p.ws + WS_PRE); const float* stat = (const float*)(p.ws + WS_STAT1);
    const float* g = p.in[26] + 3 * DM; const float* b = p.in[27] + 3 * DM;
    const int wid = tidx() >> 6, lane = tidx() & 63;
    for (int r = blockIdx.x * 8 + wid; r < NBATCH * SEQ; r += gridDim.x * 8) {
        const int bb = r / SEQ, t = r - bb * SEQ; const size_t row = (size_t)bb * LP + 64 + t;
        f32x2 sv = *(const f32x2*)(stat + (row * 16 + (lane & 15)) * 2); float s1 = sv.x, s2 = sv.y;
#pragma unroll
        for (int o = 1; o < 16; o <<= 1) { s1 += __shfl_xor(s1, o); s2 += __shfl_xor(s2, o); }
        const float mu = s1 * (1.0f / 1024.0f), var = fmaxf(s2 * (1.0f / 1024.0f) - mu * mu, 0.f), rstd = __builtin_amdgcn_rsqf(var + LN_EPS);
#pragma unroll
        for (int q = 0; q < 4; ++q) { const int c = q * 256 + lane * 4; const u32x2 w = *(const u32x2*)(xb + row * DM + c); const f32x4 v = (f32x4){bflo(w.x), bfhi(w.x), bflo(w.y), bfhi(w.y)};
            const f32x4 gg = *(const f32x4*)(g + c), bv = *(const f32x4*)(b + c);
            *(f32x4*)(p.out + (size_t)r * DM + c) = (v - mu) * rstd * gg + bv; }
    }
}

#define XB_TMO      128
#define XB_XCNT(j)  (256  + 64 * (j))
#define XB_XSUB(j)  (1280 + 64 * (j))
#define XB_XGEN(j)  (2304 + 64 * (j))
#define XB_TOP      3328
#define XB_TOPGEN   3392
#define XCD_BAR_WORDS 3456
#define XB_SPIN_CAP (1u << 20)
__device__ __forceinline__ unsigned xb_ld(unsigned* q)              { return __hip_atomic_load(q, __ATOMIC_RELAXED, __HIP_MEMORY_SCOPE_AGENT); }
__device__ __forceinline__ unsigned xb_add(unsigned* q, unsigned v) { return __hip_atomic_fetch_add(q, v, __ATOMIC_RELAXED, __HIP_MEMORY_SCOPE_AGENT); }
__device__ __forceinline__ unsigned xb_xcc_id() { return (unsigned)__builtin_amdgcn_s_getreg((3 << 11) | 20) & 0xFu; }
#define XB_SPIN(cond, bar) do { unsigned _sp = 0; while (cond) { __builtin_amdgcn_s_sleep(1); \
    if ((++_sp & 255u) == 0u) { if (xb_ld(&(bar)[XB_TMO])) break; if (_sp > XB_SPIN_CAP) { atomicAdd(&(bar)[XB_TMO], 1u); break; } } } } while (0)
struct XcdBarrier { unsigned* bar; unsigned x; volatile LAS unsigned* st; };
__device__ __forceinline__ XcdBarrier xcd_barrier_post(unsigned* bar, volatile LAS unsigned* st) {
    XcdBarrier b; b.bar = bar; b.x = xb_xcc_id(); b.st = st;
    if (threadIdx.x == 0) (void)xb_add(&bar[XB_XCNT(b.x)], 1u);
    return b;
}
__device__ __forceinline__ void xcd_barrier_complete(unsigned* bar, unsigned x, unsigned& nloc, unsigned& nx) {
    const unsigned G = gridDim.x * gridDim.y * gridDim.z;
    unsigned sum, cnt, mine, sp = 0u;
    for (;;) {
        sum = 0u; cnt = 0u; mine = 0u;
#pragma unroll
        for (unsigned j = 0; j < 16; ++j) { const unsigned c = xb_ld(&bar[XB_XCNT(j)]); sum += c; cnt += (c > 0u) ? 1u : 0u; mine = (j == x) ? c : mine; }
        if (sum == G) break;
        __builtin_amdgcn_s_sleep(1);
        if ((++sp & 255u) == 0u) { if (xb_ld(&bar[XB_TMO])) break; if (sp > XB_SPIN_CAP) { atomicAdd(&bar[XB_TMO], 1u); break; } }
    }
    nloc = mine > 0u ? mine : 1u; nx = cnt > 0u ? cnt : 1u;
}
__device__ __forceinline__ void xcd_barrier(const XcdBarrier& b) {
    asm volatile("s_waitcnt vmcnt(0)" ::: "memory");
    __syncthreads();
    if (threadIdx.x == 0) {
        unsigned* bar = b.bar;
        __builtin_amdgcn_s_waitcnt(0);
        unsigned nloc = b.st[0], nx = b.st[1];
        if (nloc == 0u) { xcd_barrier_complete(bar, b.x, nloc, nx); b.st[0] = nloc; b.st[1] = nx; }
        const unsigned old = xb_add(&bar[XB_XSUB(b.x)], 1u);
        const unsigned gen = old / nloc;
        if (old + 1u == (gen + 1u) * nloc) {
            __builtin_amdgcn_fence(__ATOMIC_RELEASE, "agent");
            asm volatile("s_waitcnt vmcnt(0)" ::: "memory");
            const unsigned og = xb_add(&bar[XB_TOP], 1u);
            const unsigned tg = og / nx;
            if (og + 1u == (tg + 1u) * nx) xb_add(&bar[XB_TOPGEN], 1u);
            else XB_SPIN(xb_ld(&bar[XB_TOPGEN]) == tg, bar);
            __builtin_amdgcn_fence(__ATOMIC_ACQUIRE, "agent");
            xb_add(&bar[XB_XGEN(b.x)], 1u);
            asm volatile("s_waitcnt vmcnt(0)" ::: "memory");
        } else {
            XB_SPIN(xb_ld(&bar[XB_XGEN(b.x)]) == gen, bar);
            __builtin_amdgcn_fence(__ATOMIC_ACQUIRE, "agent");
            asm volatile("s_waitcnt vmcnt(0)" ::: "memory");
        }
    }
    __syncthreads();
}

constexpr int NPHASE = 2 + 7 * DEPTH;
__device__ __forceinline__ void run_phase(LAS unsigned char* lds, KP& P_, int ph) {
    unsigned char* ob = (unsigned char*)p.out; unsigned char* ws = p.ws;
    if (ph == 0) { phase_init(P_); weights_units(lds, P_, -1, 0, (int)blockIdx.x, (int)gridDim.x, 0, 0); for (int lt = 0; lt < DEPTH; ++lt) tables_units(lds, P_, lt, 49 + 7 * lt); return; }
    if (ph == NPHASE - 1) { phase_final(P_); return; }
    int l = (ph - 1) / 7, k = (ph - 1) % 7; asm volatile("" : "+s"(l), "+s"(k));
    bf16_t* xb = (bf16_t*)(ws + WS_PRE);
    float* statA = (float*)(ws + WS_STAT0); float* statB = (float*)(ws + WS_STAT1);
    const bool tail_first = ((blockIdx.x >> 3) & 1) != 0;
    if (k == 0) { EpiInProj E{statB, (const float*)(ws + WS_C1IN), (const float*)(ws + WS_C2IN), (bf16_t*)(ws + WS_PROJ), (float*)(ws + WS_DT), p.in[7] + l * 6, nullptr, l > 0 ? 1 : 0};
        const int hrank = (((int)blockIdx.x >> 4) << 3) | ((int)blockIdx.x & 7), hsize = (int)gridDim.x >> 1;
        zero_tail_stats(statA);
        if (tail_first) weights_units(lds, P_, l, -1, hrank, hsize, 0, 128);
        gemm_phase(lds, xb, (const bf16_t*)(ob + OUT_WIN), 1024, 64, 12, E);
        if (!tail_first) {
            gemm_tail(lds, xb, (const bf16_t*)(ob + OUT_WIN), 1024, NPROJ, E, hrank, hsize);
            dt_units(lds, xb, (const bf16_t*)(ob + OUT_WIN), statB, (const float*)(ws + WS_C1IN), (const float*)(ws + WS_C2IN), (float*)(ws + WS_DT), l > 0 ? 1 : 0, (bf16_t*)(ws + WS_PROJ), hrank, hsize); }
    }
    else if (k == 1) { phase_mix_dyn<0>(lds, P_, l); }
    else if (k == 2) { phase_mix_b(P_, l); weights_units(lds, P_, l, l < DEPTH - 1 ? l + 1 : -1, ((int)blockIdx.x - 80 + (int)gridDim.x) % (int)gridDim.x, (int)gridDim.x, 128, 144);
    }
    else if (k == 3) { phase_mix_dyn<1>(lds, P_, l); }
    else if (k == 4) { EpiResid E{statB, l > 0 ? p.in[26] + (size_t)(l - 1) * DM : nullptr, l > 0 ? p.in[27] + (size_t)(l - 1) * DM : nullptr, xb, statA, l > 0 ? 0 : 1};
        if (tail_first) gemm_tail16(lds, (const bf16_t*)(ws + WS_MIXED), (const bf16_t*)(ob + OUT_WOUT), 1024, E);
        gemm_phase(lds, (const bf16_t*)(ws + WS_MIXED), (const bf16_t*)(ob + OUT_WOUT), 1024, 64, 4, E);
        if (!tail_first) gemm_tail16(lds, (const bf16_t*)(ws + WS_MIXED), (const bf16_t*)(ob + OUT_WOUT), 1024, E); }
    else if (k == 5) { zero_tail_stats(statB);
        EpiMlpIn E{statA, (const float*)(ws + WS_C1MLP), (const float*)(ws + WS_C2MLP), (bf16_t*)(ws + WS_HID), nullptr};
        if (tail_first) gemm_tail(lds, xb, (const bf16_t*)(ob + OUT_W1), 1024, DFF, E, (int)blockIdx.x, (int)gridDim.x);
        gemm_phase(lds, xb, (const bf16_t*)(ob + OUT_W1), 1024, 64, 16, E);
        if (!tail_first) gemm_tail(lds, xb, (const bf16_t*)(ob + OUT_W1), 1024, DFF, E, (int)blockIdx.x, (int)gridDim.x);
    }
    else { EpiResid E{statA, p.in[22] + (size_t)l * DM, p.in[23] + (size_t)l * DM, xb, statB, 0};
        if (tail_first) gemm_tail16(lds, (const bf16_t*)(ws + WS_HID), (const bf16_t*)(ob + OUT_W2), 4096, E);
        gemm_phase(lds, (const bf16_t*)(ws + WS_HID), (const bf16_t*)(ob + OUT_W2), 4096, 64, 4, E);
        if (!tail_first) gemm_tail16(lds, (const bf16_t*)(ws + WS_HID), (const bf16_t*)(ob + OUT_W2), 4096, E); }
}

#undef p
__global__ void __launch_bounds__(NTHR, 2) mega(Params p) {
    extern __shared__ __attribute__((aligned(16))) unsigned char smem[];
    LAS unsigned char* lds = (LAS unsigned char*)smem;
    const int lo = p.ph_lo, hi = p.ph_hi;
    volatile LAS unsigned* st = (volatile LAS unsigned*)(lds + LDS_BYTES - 16);
    XcdBarrier bar; bar.bar = (unsigned*)(p.ws + WS_BAR); bar.x = 0; bar.st = st;
    if (hi - lo > 1) {
        if (threadIdx.x == 0) { st[0] = 0u; st[1] = 0u; }
        __syncthreads();
        bar = xcd_barrier_post((unsigned*)(p.ws + WS_BAR), st);
    }
    if (hi > 100000) cg::this_grid().sync();
    for (int ph = lo; ph < hi; ++ph) {
        KPtr kp; kp.q = (const __attribute__((address_space(4))) Params*)__builtin_amdgcn_kernarg_segment_ptr();
        asm volatile("" : "+s"(kp.q));
        run_phase(lds, kp, ph);
        if (ph + 1 < hi) xcd_barrier(bar);
    }
}

extern "C" void kernel_launch(void* const* d_in, const int* in_sizes, int n_in, void* d_out, int out_size, void* d_ws, size_t ws_size, hipStream_t stream) {
    static int grid = 0;
    if (grid == 0) {
        if (n_in != 28 || ws_size < WS_END || out_size != NBATCH * SEQ * DM) { fprintf(stderr, "kernel_launch: unexpected shapes (n_in %d, ws %zu, out %d)\n", n_in, ws_size, out_size); grid = -1; return; }
        if (hipFuncSetAttribute((const void*)mega, hipFuncAttributeMaxDynamicSharedMemorySize, LDS_BYTES) != hipSuccess) { fprintf(stderr, "kernel_launch: hipFuncSetAttribute failed\n"); grid = -1; return; }
        int dev = 0, cus = 0, per_cu = 0; hipGetDevice(&dev); hipDeviceGetAttribute(&cus, hipDeviceAttributeMultiprocessorCount, dev);
        hipOccupancyMaxActiveBlocksPerMultiprocessor(&per_cu, (const void*)mega, NTHR, LDS_BYTES);
        if (per_cu < 1) { fprintf(stderr, "kernel_launch: occupancy query says %d blocks per CU\n", per_cu); per_cu = 1; }
        grid = cus * 1;
    }
    if (grid < 0) return;
    Params p{};
    for (int i = 0; i < 28; ++i) p.in[i] = (const float*)d_in[i];
    p.out = (float*)d_out; p.ws = (unsigned char*)d_ws;
#if COOP
    if (hipMemsetAsync((char*)d_ws + WS_BAR, 0, 16384, stream) != hipSuccess) { fprintf(stderr, "kernel_launch: memset failed\n"); return; }
    p.ph_lo = 0; p.ph_hi = NPHASE;
    void* args[] = {&p};
    hipError_t e = hipLaunchCooperativeKernel((const void*)mega, dim3(grid), dim3(NTHR), args, LDS_BYTES, stream);
    if (e != hipSuccess) fprintf(stderr, "cooperative launch failed: %s (grid %d)\n", hipGetErrorString(e), grid);
#else
    for (int ph = 0; ph < NPHASE; ++ph) { p.ph_lo = ph; p.ph_hi = ph + 1; hipLaunchKernelGGL(mega, dim3(grid), dim3(NTHR), LDS_BYTES, stream, p); }
#endif
}
```

```cpp
#include <hip/hip_runtime.h>
#include <hip/hip_cooperative_groups.h>
#include <cstdio>
namespace cg = cooperative_groups;

#ifndef COOP
#define COOP 1
#endif

#define LAS __attribute__((address_space(3)))
typedef unsigned short bf16_t;
typedef short bf16x8 __attribute__((ext_vector_type(8)));
typedef float f32x4 __attribute__((ext_vector_type(4)));
typedef float f32x2 __attribute__((ext_vector_type(2)));
typedef unsigned u32x4 __attribute__((ext_vector_type(4)));
typedef unsigned u32x2 __attribute__((ext_vector_type(2)));

constexpr int DM = 1024, NBATCH = 4, SEQ = 4096, DEPTH = 4;
constexpr int LP = 4160, MR = 16640, NCHB = 65, NCHT = 260, PADR = 48;
constexpr int NPROJ = 3072, NINP = 3328, DFF = 4096, DIN = 3078;
constexpr int C_F = 384, C_I = 768, C_G = 1152, C_Z = 1536, C_X = 1920, C_B = 2304, C_C = 2560, C_U = 2816;
constexpr float ALPHA = 1.681792830507429f;
constexpr float LN_EPS = 1e-5f, RMS_EPS = 1e-6f;
constexpr int NTHR = 512;
constexpr int LDS_BYTES = 147456;
constexpr int RS_OFF = 131072;

constexpr size_t WS_PROJ = 0, WS_HID = 0;
constexpr size_t WS_MIXED = 102236160;
constexpr size_t WS_PRE = 136314880;
constexpr size_t WS_STH = 204472320;
constexpr size_t WS_STM = 217251840;
constexpr size_t WS_STS = 242810880;
constexpr size_t WS_DECH = 244940800;
constexpr size_t WS_DECM = 245340160;
constexpr size_t WS_DT = 245348352;
constexpr size_t WS_STAT0 = 245880832;
constexpr size_t WS_STAT1 = 248010752;
constexpr size_t WS_C1IN = 250140672;
constexpr size_t WS_C2IN = WS_C1IN + 13312;
constexpr size_t WS_C1MLP = WS_C2IN + 13312;
constexpr size_t WS_C2MLP = WS_C1MLP + 16384;
constexpr size_t WS_LB = WS_C2MLP + 16384;
constexpr size_t WS_S5LAM = WS_LB + 2048;
constexpr size_t WS_S5BB = WS_S5LAM + 16384;
constexpr size_t WS_S5C = WS_S5BB + 131072;
constexpr size_t WS_GLUT = WS_S5C + 65536;
constexpr size_t WS_BAR = WS_GLUT + 131072;
constexpr size_t WS_S5BBH = WS_BAR + 16384;
constexpr size_t WS_TBL = WS_S5BBH + 65536;
constexpr size_t T_LB = 0, T_S5LAM = 2048, T_S5BBH = 18432, T_S5C = 83968, T_GLUT = 149504, TBL_STRIDE = 280576;
#define TBL(off, l) (WS_TBL + (size_t)(l) * TBL_STRIDE + (off))
constexpr size_t WS_END = WS_TBL + 4 * TBL_STRIDE;
constexpr size_t OUT_XB = 0, OUT_WIN = 34078720, OUT_WOUT = 40894464, OUT_W1 = 42991616, OUT_W2 = 51380224;

struct Params { const float* in[28]; float* out; unsigned char* ws; int ph_lo, ph_hi; };
struct KPtr { const __attribute__((address_space(4))) Params* q; };
typedef const KPtr KP;
#define p (*P_.q)

typedef __bf16 bf16v2 __attribute__((ext_vector_type(2)));
__device__ __forceinline__ unsigned cvt_pk_bf16(float lo, float hi) { const bf16v2 v = __builtin_convertvector((f32x2){lo, hi}, bf16v2); return __builtin_bit_cast(unsigned, v); }
__device__ __forceinline__ bf16_t f2bf(float f) { return (bf16_t)(cvt_pk_bf16(f, 0.f) & 0xffffu); }
__device__ __forceinline__ float bf2f(bf16_t b) { return __uint_as_float(((unsigned)b) << 16); }
__device__ __forceinline__ float bflo(unsigned w) { return __uint_as_float(w << 16); }
__device__ __forceinline__ float bfhi(unsigned w) { return __uint_as_float(w & 0xffff0000u); }
__device__ __forceinline__ void unpack8(const u32x4 v, float* o) { o[0] = bflo(v.x); o[1] = bfhi(v.x); o[2] = bflo(v.y); o[3] = bfhi(v.y); o[4] = bflo(v.z); o[5] = bfhi(v.z); o[6] = bflo(v.w); o[7] = bfhi(v.w); }
__device__ __forceinline__ u32x4 pack8(const float* o) { u32x4 v; v.x = cvt_pk_bf16(o[0], o[1]); v.y = cvt_pk_bf16(o[2], o[3]); v.z = cvt_pk_bf16(o[4], o[5]); v.w = cvt_pk_bf16(o[6], o[7]); return v; }
__device__ __forceinline__ u32x2 pack4(const f32x4 a) { u32x2 v; v.x = cvt_pk_bf16(a[0], a[1]); v.y = cvt_pk_bf16(a[2], a[3]); return v; }
__device__ __forceinline__ float sigmoidf_(float x) { return __builtin_amdgcn_rcpf(1.0f + __expf(-x)); }
__device__ __forceinline__ float siluf_(float x) { return x * __builtin_amdgcn_rcpf(1.0f + __expf(-x)); }
__device__ __forceinline__ float softplusf_(float x) { return x > 20.f ? x : log1pf(expf(x)); }
__device__ __forceinline__ float gelu_tanh(float x) { const float e = __builtin_amdgcn_exp2f(x * (-2.302208198f - 0.102943240f * x * x)); return x * __builtin_amdgcn_rcpf(1.0f + e); }
__device__ __forceinline__ int tidx() { int t = threadIdx.x; asm volatile("" : "+v"(t)); return t; }
#define LBAR() do { asm volatile("s_waitcnt lgkmcnt(0)" ::: "memory"); __builtin_amdgcn_s_barrier(); asm volatile("" ::: "memory"); } while (0)
#define MFMA16(a, b, c) __builtin_amdgcn_mfma_f32_16x16x32_bf16((a), (b), (c), 0, 0, 0)

__device__ void phase_init(KP& P_) {
    const float* x = p.in[0]; const float* meta = p.in[1];
    bf16_t* xb = (bf16_t*)(p.ws + WS_PRE);
    const size_t total = (size_t)MR * 256, GT = (size_t)gridDim.x * NTHR;
    for (size_t i0 = (size_t)blockIdx.x * NTHR + tidx(); i0 < total; i0 += 4 * GT) {
        f32x4 v[4];
#pragma unroll
        for (int q = 0; q < 4; ++q) { const size_t i = i0 + q * GT; v[q] = (f32x4){0.f, 0.f, 0.f, 0.f};
            if (i < total) { const int row = (int)(i >> 8), c4 = (int)(i & 255) * 4; const int b = row / LP, r = row - b * LP;
                if (r >= 64) v[q] = *(const f32x4*)(x + ((size_t)(b * SEQ + r - 64)) * DM + c4);
                else if (r >= PADR) v[q] = *(const f32x4*)(meta + (size_t)(r - PADR) * DM + c4); } }
#pragma unroll
        for (int q = 0; q < 4; ++q) { const size_t i = i0 + q * GT; if (i < total) { const int row = (int)(i >> 8), c4 = (int)(i & 255) * 4; *(u32x2*)(xb + (size_t)row * DM + c4) = pack4(v[q]); } }
    }
}

__device__ void conv_unit(LAS unsigned char* lds, const float* src, int ld, int sn0, int nvalid, int k0, int krows,
                          bf16_t* dst, int dn0, int Kdst, int kd0, const float* gs, const float* bs, float* c1, float* c2) {
    LAS bf16_t* T = (LAS bf16_t*)lds;
    LAS float* red = (LAS float*)(lds + 9216);
    const int tid = tidx(), kl = tid >> 3, ng = (tid & 7) * 8;
    float a1[8], a2[8], wn[8], gn, bn;
#pragma unroll
    for (int j = 0; j < 8; ++j) { a1[j] = 0.f; a2[j] = 0.f; }
    const int nkt = krows / 64;
    { const int k = k0 + kl; gn = gs ? gs[k] : 1.f; bn = bs ? bs[k] : 0.f;
#pragma unroll
      for (int j = 0; j < 8; ++j) wn[j] = (ng + j < nvalid) ? src[(size_t)k * ld + sn0 + ng + j] : 0.f; }
    for (int kt = 0; kt < nkt; ++kt) {
        float w[8]; const float g = gn, b = bn;
#pragma unroll
        for (int j = 0; j < 8; ++j) w[j] = wn[j];
        if (kt + 1 < nkt) { const int k = k0 + (kt + 1) * 64 + kl; gn = gs ? gs[k] : 1.f; bn = bs ? bs[k] : 0.f;
#pragma unroll
            for (int j = 0; j < 8; ++j) wn[j] = (ng + j < nvalid) ? src[(size_t)k * ld + sn0 + ng + j] : 0.f; }
#pragma unroll
        for (int j = 0; j < 8; ++j) { const bf16_t wb = f2bf(w[j] * g); a1[j] += bf2f(wb); a2[j] += b * w[j]; T[(ng + j) * 72 + kl] = wb; }
        LBAR();
        { const int n = tid >> 3, ks = (tid & 7) * 8; const u32x4 v = *(const LAS u32x4*)(T + n * 72 + ks);
          *(u32x4*)(dst + (size_t)(dn0 + n) * Kdst + kd0 + kt * 64 + ks) = v; }
        LBAR();
    }
    if (c1) {
#pragma unroll
        for (int j = 0; j < 8; ++j) red[kl * 65 + ng + j] = a1[j];
        LBAR();
        if (tid < 64) { float sm = 0.f; for (int q = 0; q < 64; ++q) sm += red[q * 65 + tid]; c1[dn0 + tid] = sm; }
        LBAR();
#pragma unroll
        for (int j = 0; j < 8; ++j) red[kl * 65 + ng + j] = a2[j];
        LBAR();
        if (tid < 64) { float sm = 0.f; for (int q = 0; q < 64; ++q) sm += red[q * 65 + tid]; c2[dn0 + tid] = sm; }
        LBAR();
    }
}

__device__ void weights_units(LAS unsigned char* lds, KP& P0, int lm0, int li0, int ufirst, int ustride) {
    const int n_m = lm0 >= 0 ? 144 : 0, n_i = li0 >= 0 ? 49 : 0, NU = n_m + n_i;
    for (int u = ufirst; u < NU; u += ustride) {
        KPtr P_ = P0; int lm = __builtin_amdgcn_readfirstlane(lm0), li = __builtin_amdgcn_readfirstlane(li0); asm volatile("" : "+s"(P_.q), "+s"(lm), "+s"(li));
        unsigned char* ob = (unsigned char*)p.out; unsigned char* ws = p.ws;
        if (u < n_m) {
            if (u < 64) { const float* w1 = p.in[24] + (size_t)lm * DM * DFF;
                conv_unit(lds, w1, DFF, u * 64, 64, 0, 1024, (bf16_t*)(ob + OUT_W1), u * 64, 1024, 0, p.in[22] + (size_t)lm * DM, p.in[23] + (size_t)lm * DM, (float*)(ws + WS_C1MLP), (float*)(ws + WS_C2MLP)); }
            else if (u < 128) { const int j = (u - 64) & 15, kq = (u - 64) >> 4; const float* w2 = p.in[25] + (size_t)lm * DFF * DM;
                conv_unit(lds, w2, DM, j * 64, 64, kq * 1024, 1024, (bf16_t*)(ob + OUT_W2), j * 64, DFF, kq * 1024, nullptr, nullptr, nullptr, nullptr); }
            else { const int j = u - 128; const float* w_out = p.in[21] + (size_t)lm * DM * DM;
                conv_unit(lds, w_out, DM, j * 64, 64, 0, 1024, (bf16_t*)(ob + OUT_WOUT), j * 64, 1024, 0, nullptr, nullptr, nullptr, nullptr); }
        } else {
            const int j = u - n_m; int sn0, nvalid = 64;
            if (j < 44) sn0 = j * 64; else if (j < 48) sn0 = 2822 + (j - 44) * 64; else { sn0 = 2816; nvalid = 6; }
            const float* w_in = p.in[2] + (size_t)li * DM * DIN;
            const float* g_in = li > 0 ? p.in[26] + (size_t)(li - 1) * DM : nullptr; const float* b_in = li > 0 ? p.in[27] + (size_t)(li - 1) * DM : nullptr;
            conv_unit(lds, w_in, DIN, sn0, nvalid, 0, 1024, (bf16_t*)(ob + OUT_WIN), j * 64, 1024, 0, g_in, b_in, (float*)(ws + WS_C1IN), (float*)(ws + WS_C2IN));
        }
    }
}
__device__ void tables_units(LAS unsigned char* lds, KP& P0, int l0, int wg0) {
    const int G = gridDim.x;
    for (int u = ((int)blockIdx.x - wg0 + G) % G; u < 7; u += G) {
        KPtr P_ = P0; int l = l0; asm volatile("" : "+s"(P_.q), "+s"(l));
        unsigned char* ws = p.ws;
        if (u < 4) conv_unit(lds, p.in[19] + (size_t)l * 65536, 256, u * 64, 64, 0, 256, (bf16_t*)(ws + TBL(T_GLUT, l)), u * 64, 256, 0, nullptr, nullptr, nullptr, nullptr);
        else if (u < 6) {
            const int id = (u - 4) * 512 + tidx(), g = id >> 6, n = id & 63; const int gi = (l * 16 + g) * 64 + n;
            const float lre = fminf(p.in[11][gi], -1e-4f), lim = p.in[12][gi], dt = expf(p.in[13][l * 16 + g]);
            const float mag = expf(lre * dt); const float lbr = mag * cosf(lim * dt), lbi = mag * sinf(lim * dt);
            const float den = lre * lre + lim * lim, nr = lbr - 1.0f;
            const float sre = (nr * lre + lbi * lim) / den, sim = (lbi * lre - nr * lim) / den;
            float pr = lbr, pi = lbi;
            for (int q = 0; q < 6; ++q) { const float t = pr * pr - pi * pi; pi = 2.f * pr * pi; pr = t; }
            float* lam = (float*)(ws + TBL(T_S5LAM, l)) + (size_t)(g * 64 + n) * 4; lam[0] = lbr; lam[1] = lbi; lam[2] = pr; lam[3] = pi;
            float bb[32];
            bf16_t* bbh = (bf16_t*)(ws + TBL(T_S5BBH, l)) + (size_t)(g * 128 + 2 * n) * 16;
            for (int c = 0; c < 16; ++c) { const float br = p.in[14][(size_t)gi * 16 + c], bi = p.in[15][(size_t)gi * 16 + c]; bb[c] = sre * br - sim * bi; bb[16 + c] = sre * bi + sim * br; bbh[c] = f2bf(bb[c]); bbh[16 + c] = f2bf(bb[16 + c]); }
            bf16_t* cm = (bf16_t*)(ws + TBL(T_S5C, l));
            for (int c = 0; c < 16; ++c) { const size_t ci = ((size_t)(l * 16 + g) * 16 + c) * 64 + n; cm[(size_t)(g * 16 + c) * 128 + 2 * n] = f2bf(p.in[16][ci]); cm[(size_t)(g * 16 + c) * 128 + 2 * n + 1] = f2bf(-p.in[17][ci]); }
        } else {
            if (tidx() < 384) { const int c = tidx(); float v[4], mx = -1e30f; for (int q = 0; q < 4; ++q) { v[q] = p.in[3][q * 384 + c]; mx = fmaxf(mx, v[q]); }
                float sm = 0.f; for (int q = 0; q < 4; ++q) { v[q] = expf(v[q] - mx); sm += v[q]; } float a = 0.f; for (int q = 1; q <= l; ++q) a += v[q] / sm;
                ((float*)(ws + TBL(T_LB, l)))[c] = a; }
        }
    }
}

constexpr int HTB = 16384;
__device__ __forceinline__ int lds_byte(int r, int c) { const int st = (r >> 4) * 2 + (c >> 5), rr = r & 15, cc = c & 31, ob = rr * 64 + cc * 2; return st * 1024 + (ob ^ (((ob >> 9) & 1) << 5)); }
__device__ __forceinline__ void stage_rc(int b, int& R, int& C) { const int st = b / 1024, sb = b % 1024, swz = sb ^ (((sb >> 9) & 1) << 5); R = (st >> 1) * 16 + swz / 64; C = (st & 1) * 32 + (swz % 64) / 2; }

struct RowInfo { float mu, rstd; int pad; };

__device__ __forceinline__ int prow0(int pm) { return (pm >> 4) * LP + PADR + (pm & 15) * 256; }
__device__ __forceinline__ int trow(int i) { return (i >> 4) * LP + 4144 + (i & 15); }
__device__ __forceinline__ void prep_rowstats(const float* stat, int pm, int par, LAS unsigned char* lds) {
    const int t = tidx();
    if (t < (pm < 64 ? 256 : 64)) {
        const int row = pm < 64 ? prow0(pm) + t : trow(t); const f32x4* sp = (const f32x4*)(stat + (size_t)row * 32);
        float s1 = 0.f, s2 = 0.f;
#pragma unroll
        for (int q = 0; q < 8; ++q) { const f32x4 v = sp[q]; s1 += v[0] + v[2]; s2 += v[1] + v[3]; }
        const float mu = s1 * (1.0f / 1024.0f); const float var = fmaxf(s2 * (1.0f / 1024.0f) - mu * mu, 0.f);
        ((LAS f32x2*)(lds + RS_OFF + par * 2048))[t] = (f32x2){mu, __builtin_amdgcn_rsqf(var + LN_EPS)};
    }
}

struct ColInfo { f32x4 a, b; };
struct EpiInProj {
    static constexpr bool STATS = false, PRELOAD = false;
    const float* stat; const float* c1; const float* c2; bf16_t* proj; float* dtbuf; const float* dtbias; float* stat_out; int fold;
    __device__ __forceinline__ void prep(int pm, int par, LAS unsigned char* lds) const { if (fold) prep_rowstats(stat, pm, par, lds); }
    __device__ __forceinline__ RowInfo rowinfo(int row, int lrow, int par, LAS unsigned char* lds) const {
        RowInfo r; r.mu = 0.f; r.rstd = 1.f; if (fold) { const f32x2 sv = ((const LAS f32x2*)(lds + RS_OFF + par * 2048))[lrow]; r.mu = sv.x; r.rstd = sv.y; }
        r.pad = 0; return r; }
    __device__ __forceinline__ ColInfo colinfo(int col) const { ColInfo c; c.a = (f32x4){0.f, 0.f, 0.f, 0.f}; c.b = c.a; if (fold) { c.a = *(const f32x4*)(c1 + col); c.b = *(const f32x4*)(c2 + col); } return c; }
    __device__ __forceinline__ f32x4 preload(int row, int col) const { return (f32x4){0.f, 0.f, 0.f, 0.f}; }
    __device__ __forceinline__ u32x2 preload_pk(int row, int col) const { return (u32x2){0u, 0u}; }
    __device__ __forceinline__ void apply(const RowInfo& ri, const ColInfo& ci, int row, int col, f32x4 a, f32x4 pv, float& s1, float& s2) const {
        f32x4 v = a;
        if (fold) v = (a - ci.a * ri.mu) * ri.rstd + ci.b;
        if (ri.pad) v = (f32x4){0.f, 0.f, 0.f, 0.f};
        *(u32x2*)(proj + (size_t)row * NPROJ + col) = pack4(v);
    }
};
struct EpiResid {
    static constexpr bool STATS = true, PRELOAD = true;
    const float* stat; const float* g; const float* b; bf16_t* xb; float* stat_out; int ident;
    __device__ __forceinline__ void prep(int pm, int par, LAS unsigned char* lds) const { if (!ident) prep_rowstats(stat, pm, par, lds); }
    __device__ __forceinline__ RowInfo rowinfo(int row, int lrow, int par, LAS unsigned char* lds) const {
        RowInfo r; r.mu = 0.f; r.rstd = 1.f; r.pad = 0; if (!ident) { const f32x2 sv = ((const LAS f32x2*)(lds + RS_OFF + par * 2048))[lrow]; r.mu = sv.x; r.rstd = sv.y; } return r; }
    __device__ __forceinline__ ColInfo colinfo(int col) const { ColInfo c; c.a = (f32x4){0.f, 0.f, 0.f, 0.f}; c.b = c.a; return c; }
    __device__ __forceinline__ f32x4 preload(int row, int col) const { const u32x2 w = *(const u32x2*)(xb + (size_t)row * DM + col); return (f32x4){bflo(w.x), bfhi(w.x), bflo(w.y), bfhi(w.y)}; }
    __device__ __forceinline__ u32x2 preload_pk(int row, int col) const { return *(const u32x2*)(xb + (size_t)row * DM + col); }
    __device__ __forceinline__ void apply(const RowInfo& ri, const ColInfo& ci, int row, int col, f32x4 a, f32x4 pv, float& s1, float& s2) const {
        f32x4 h = pv;
        if (!ident) { const f32x4 gg = *(const f32x4*)(g + col), bb = *(const f32x4*)(b + col); h = (pv - ri.mu) * ri.rstd * gg + bb; }
        const f32x4 v = h * ALPHA + a;
        *(u32x2*)(xb + (size_t)row * DM + col) = pack4(v);
        s1 += (v[0] + v[1]) + (v[2] + v[3]); s2 += (v[0] * v[0] + v[1] * v[1]) + (v[2] * v[2] + v[3] * v[3]);
    }
};
struct EpiMlpIn {
    static constexpr bool STATS = false, PRELOAD = false;
    const float* stat; const float* c1; const float* c2; bf16_t* hid; float* stat_out;
    __device__ __forceinline__ void prep(int pm, int par, LAS unsigned char* lds) const { prep_rowstats(stat, pm, par, lds); }
    __device__ __forceinline__ RowInfo rowinfo(int row, int lrow, int par, LAS unsigned char* lds) const {
        RowInfo r; const f32x2 sv = ((const LAS f32x2*)(lds + RS_OFF + par * 2048))[lrow]; r.mu = sv.x; r.rstd = sv.y; r.pad = 0; return r; }
    __device__ __forceinline__ ColInfo colinfo(int col) const { ColInfo c; c.a = *(const f32x4*)(c1 + col); c.b = *(const f32x4*)(c2 + col); return c; }
    __device__ __forceinline__ f32x4 preload(int row, int col) const { return (f32x4){0.f, 0.f, 0.f, 0.f}; }
    __device__ __forceinline__ u32x2 preload_pk(int row, int col) const { return (u32x2){0u, 0u}; }
    __device__ __forceinline__ void apply(const RowInfo& ri, const ColInfo& ci, int row, int col, f32x4 a, f32x4 pv, float& s1, float& s2) const {
        f32x4 v = (a - ci.a * ri.mu) * ri.rstd + ci.b;
#pragma unroll
        for (int j = 0; j < 4; ++j) { const float r = fmaxf(v[j], 0.f); v[j] = r * r; }
        *(u32x2*)(hid + (size_t)row * DFF + col) = pack4(v);
    }
};

template <class Epi>
__device__ __forceinline__ void gemm_phase(LAS unsigned char* lds, const bf16_t* Ag, const bf16_t* Btg, const int K, const int nM, const int nN, const Epi& E) {
    const int tid = tidx(), wid = __builtin_amdgcn_readfirstlane(tid >> 6), lane = tid & 63, wr = wid >> 2, wc = wid & 3, fr = lane & 15, fq = lane >> 4;
    const int nt = K / 64, G = gridDim.x, nunits = nM * nN;
    int u = blockIdx.x; if (u >= nunits) return;
    unsigned voff[2];
#pragma unroll
    for (int i = 0; i < 2; ++i) { int R, C; stage_rc(tid * 16 + i * 8192, R, C); voff[i] = (unsigned)(R * K + C) * 2u; }
    const size_t kstep = 128, hstep = (size_t)128 * K * 2, tstep = 2 * hstep;
    const unsigned ldsw = (unsigned)wid * 1024u;
    const int aoff = lds_byte(wr * 64 + fr, fq * 8), boff = lds_byte(wc * 32 + fr, fq * 8);
#define G_SA(b, h) (((b) * 2 + (h)) * HTB)
#define G_SB(b, h) ((4 + (b) * 2 + (h)) * HTB)
#define G_STAGE(bufoff, gbase) do { _Pragma("unroll") for (int _i = 0; _i < 2; ++_i) \
        __builtin_amdgcn_global_load_lds((const unsigned*)((const char*)(gbase) + voff[_i]), (LAS unsigned*)(lds + (bufoff) + ldsw + _i * 8192), 16, 0, 0); } while (0)
#define G_LDA(dst, b, h) do { _Pragma("unroll") for (int m = 0; m < 4; ++m) _Pragma("unroll") for (int k = 0; k < 2; ++k) dst[m][k] = *(const LAS bf16x8*)(lds + G_SA(b, h) + aoff + m * 2048 + k * 1024); } while (0)
#define G_LDB(dst, b, h) do { _Pragma("unroll") for (int n = 0; n < 2; ++n) _Pragma("unroll") for (int k = 0; k < 2; ++k) dst[n][k] = *(const LAS bf16x8*)(lds + G_SB(b, h) + boff + n * 2048 + k * 1024); } while (0)
#define G_MMA(ai, bj, At, Bt) do { __builtin_amdgcn_s_setprio(1); _Pragma("unroll") for (int m = 0; m < 4; ++m) _Pragma("unroll") for (int n = 0; n < 2; ++n) _Pragma("unroll") for (int k = 0; k < 2; ++k) \
        acc[ai][bj][m][n] = MFMA16(Bt[n][k], At[m][k], acc[ai][bj][m][n]); __builtin_amdgcn_s_setprio(0); } while (0)
#define G_WAIT_V(n) asm volatile("s_waitcnt vmcnt(" #n ")" ::: "memory")
#define G_WAIT_L(n) asm volatile("s_waitcnt lgkmcnt(" #n ")" ::: "memory")
#define G_BAR __builtin_amdgcn_s_barrier()
#define G_SCHED __builtin_amdgcn_sched_barrier(0)
    int pm = u % nM, pn = u / nM, par = 0;
    f32x4 acc[2][2][4][2];
#pragma unroll
    for (int a = 0; a < 2; ++a)
#pragma unroll
        for (int b = 0; b < 2; ++b)
#pragma unroll
            for (int m = 0; m < 4; ++m)
#pragma unroll
                for (int n = 0; n < 2; ++n) acc[a][b][m][n] = (f32x4){0.f, 0.f, 0.f, 0.f};
    bf16x8 At[4][2], B0[2][2], B1[2][2];
    const size_t rstep = (size_t)K * 2;
    const char* cA = (const char*)Ag + (size_t)prow0(pm) * rstep; const char* cB = (const char*)Btg + (size_t)pn * tstep;
    E.prep(pm, par, lds);
    G_STAGE(G_SB(0, 0), cB); G_STAGE(G_SA(0, 0), cA); G_STAGE(G_SB(0, 1), cB + hstep); G_STAGE(G_SA(0, 1), cA + hstep);
    if (wr == 1) G_BAR;
    G_WAIT_V(4); G_BAR;
    G_STAGE(G_SB(1, 0), cB + kstep); G_STAGE(G_SA(1, 0), cA + kstep); G_STAGE(G_SB(1, 1), cB + hstep + kstep);
    G_WAIT_V(6); G_BAR;
    for (;;) {
        const int un = u + G; const bool has_next = un < nunits; const int pmn = has_next ? un % nM : pm, pnn = has_next ? un / nM : pn;
        const char* nA = has_next ? (const char*)Ag + (size_t)prow0(pmn) * rstep : cA; const char* nB = has_next ? (const char*)Btg + (size_t)pnn * tstep : cB;
        for (int t = 0; t < nt; t += 2) {
            const bool last = (t == nt - 2);
            const char* a1 = cA + (size_t)(t + 1) * kstep;
            const char* a2 = last ? nA : cA + (size_t)(t + 2) * kstep; const char* b2 = last ? nB : cB + (size_t)(t + 2) * kstep;
            const char* a3 = a2 + kstep; const char* b3 = b2 + kstep;
            if (last && has_next && pmn != pm) E.prep(pmn, par ^ 1, lds);
            G_LDB(B0, 0, 0); G_SCHED; G_LDA(At, 0, 0); G_STAGE(G_SA(1, 1), a1 + hstep);
            G_WAIT_L(8); G_BAR; G_WAIT_L(0); G_MMA(0, 0, At, B0); G_BAR; G_SCHED;
            G_LDB(B1, 0, 1); G_STAGE(G_SB(0, 0), b2);
            G_BAR; G_WAIT_L(0); G_MMA(0, 1, At, B1); G_BAR;
            G_LDA(At, 0, 1); G_STAGE(G_SA(0, 0), a2);
            G_BAR; G_WAIT_L(0); G_MMA(1, 0, At, B0); G_BAR; G_SCHED;
            G_STAGE(G_SB(0, 1), b2 + hstep);
            G_WAIT_V(6); G_BAR; G_MMA(1, 1, At, B1); G_BAR;
            G_LDB(B0, 1, 0); G_SCHED; G_LDA(At, 1, 0); G_STAGE(G_SA(0, 1), a2 + hstep);
            G_WAIT_L(8); G_BAR; G_WAIT_L(0); G_MMA(0, 0, At, B0); G_BAR; G_SCHED;
            G_LDB(B1, 1, 1); G_STAGE(G_SB(1, 0), b3);
            G_BAR; G_WAIT_L(0); G_MMA(0, 1, At, B1); G_BAR;
            G_LDA(At, 1, 1); G_STAGE(G_SA(1, 0), a3);
            G_BAR; G_WAIT_L(0); G_MMA(1, 0, At, B0); G_BAR; G_SCHED;
            G_STAGE(G_SB(1, 1), b3 + hstep);
            G_WAIT_V(6); G_BAR; G_MMA(1, 1, At, B1); G_BAR;
        }
        {
            ColInfo ci[2][2];
#pragma unroll
            for (int bj = 0; bj < 2; ++bj)
#pragma unroll
                for (int n = 0; n < 2; ++n) ci[bj][n] = E.colinfo(pn * 256 + bj * 128 + wc * 32 + n * 16 + fq * 4);
            u32x2 pk[4][2][2];
#pragma unroll
            for (int gi = 0; gi < 8; ++gi) {
                const int ai = gi >> 2, m = gi & 3;
                const int lrow = ai * 128 + wr * 64 + m * 16 + fr, row = prow0(pm) + lrow;
                if (!Epi::PRELOAD && gi == 0) {
#pragma unroll
                    for (int g2 = 0; g2 < 4; ++g2)
#pragma unroll
                        for (int bj = 0; bj < 2; ++bj)
#pragma unroll
                            for (int n = 0; n < 2; ++n) pk[g2][bj][n] = (u32x2){0u, 0u};
                }
                if (Epi::PRELOAD && m == 0) {
#pragma unroll
                    for (int g2 = 0; g2 < 4; ++g2)
#pragma unroll
                        for (int bj = 0; bj < 2; ++bj)
#pragma unroll
                            for (int n = 0; n < 2; ++n) pk[g2][bj][n] = E.preload_pk(prow0(pm) + ai * 128 + wr * 64 + g2 * 16 + fr, pn * 256 + bj * 128 + wc * 32 + n * 16 + fq * 4);
                }
                f32x4 pv[2][2];
#pragma unroll
                for (int bj = 0; bj < 2; ++bj)
#pragma unroll
                    for (int n = 0; n < 2; ++n) { const u32x2 w = pk[m][bj][n]; pv[bj][n] = (f32x4){bflo(w.x), bfhi(w.x), bflo(w.y), bfhi(w.y)}; }
                const RowInfo ri = E.rowinfo(row, lrow, par, lds);
                float s1 = 0.f, s2 = 0.f;
#pragma unroll
                for (int bj = 0; bj < 2; ++bj)
#pragma unroll
                    for (int n = 0; n < 2; ++n) E.apply(ri, ci[bj][n], row, pn * 256 + bj * 128 + wc * 32 + n * 16 + fq * 4, acc[ai][bj][m][n], pv[bj][n], s1, s2);
                if (Epi::STATS) {
                    s1 += __shfl_xor(s1, 16); s1 += __shfl_xor(s1, 32); s2 += __shfl_xor(s2, 16); s2 += __shfl_xor(s2, 32);
                    if (fq == 0) *(f32x2*)(E.stat_out + ((size_t)row * 16 + pn * 4 + wc) * 2) = (f32x2){s1, s2};
                }
                asm volatile("" ::: "memory");
            }
        }
        if (!has_next) break;
#pragma unroll
        for (int a = 0; a < 2; ++a)
#pragma unroll
            for (int b = 0; b < 2; ++b)
#pragma unroll
                for (int m = 0; m < 4; ++m)
#pragma unroll
                    for (int n = 0; n < 2; ++n) acc[a][b][m][n] = (f32x4){0.f, 0.f, 0.f, 0.f};
        if (pmn != pm) par ^= 1;
        u = un; pm = pmn; pn = pnn; cA = nA; cB = nB;
    }
    G_WAIT_V(0);
    if (wr == 0) G_BAR;
    G_BAR;
}


template <class Epi>
__device__ __forceinline__ void gemm_tail(LAS unsigned char* lds, const bf16_t* Ag, const bf16_t* Btg, const int K, const int N, const Epi& E, const int ufirst, const int ustride) {
    const int tid = tidx(), wid = tid >> 6, lane = tid & 63, fr = lane & 15, fq = lane >> 4;
    LAS float* red = (LAS float*)lds;
    const int nunits = 4 * (N / 64), ks = K / 8, nch = ks / 128, G = ustride;
    int u = ufirst;
    bf16x8 af[4], bf[4][4];
#define T_LOAD(uu, cc) do { const int _rb = (uu) & 3, _cb = (uu) >> 2; \
        const bf16_t* _ap = Ag + (size_t)trow(_rb * 16 + fr) * K + wid * ks + (cc) * 128 + fq * 8; \
        const bf16_t* _bp = Btg + (size_t)(_cb * 64 + fr) * K + wid * ks + (cc) * 128 + fq * 8; \
        _Pragma("unroll") for (int s_ = 0; s_ < 4; ++s_) { af[s_] = *(const bf16x8*)(_ap + s_ * 32); \
            _Pragma("unroll") for (int n_ = 0; n_ < 4; ++n_) bf[s_][n_] = *(const bf16x8*)(_bp + (size_t)n_ * 16 * K + s_ * 32); } } while (0)
    if (u < nunits) T_LOAD(u, 0);
    E.prep(64, 0, lds);
    LBAR();
    if (u >= nunits) return;
    int c = 0;
    f32x4 acc[4];
#pragma unroll
    for (int n = 0; n < 4; ++n) acc[n] = (f32x4){0.f, 0.f, 0.f, 0.f};
    for (;;) {
        bf16x8 caf[4], cbf[4][4];
#pragma unroll
        for (int s_ = 0; s_ < 4; ++s_) { caf[s_] = af[s_];
#pragma unroll
            for (int n_ = 0; n_ < 4; ++n_) cbf[s_][n_] = bf[s_][n_]; }
        const bool lastc = (c + 1 == nch); const int un = lastc ? u + G : u, cn = lastc ? 0 : c + 1; const bool more = un < nunits;
        ColInfo cie; cie.a = (f32x4){0.f, 0.f, 0.f, 0.f}; cie.b = cie.a; f32x4 pve = (f32x4){0.f, 0.f, 0.f, 0.f};
        if (lastc && tid < 256) { const int ecol = (u >> 2) * 64 + (tid & 15) * 4; cie = E.colinfo(ecol); pve = E.preload(trow((u & 3) * 16 + (tid >> 4)), ecol); }
        if (more) T_LOAD(un, cn);
#pragma unroll
        for (int s_ = 0; s_ < 4; ++s_)
#pragma unroll
            for (int n_ = 0; n_ < 4; ++n_) acc[n_] = MFMA16(cbf[s_][n_], caf[s_], acc[n_]);
        if (lastc) {
            const int rb = u & 3, cb = u >> 2;
#pragma unroll
            for (int n = 0; n < 4; ++n) { *(LAS f32x4*)(red + (wid * 16 + fr) * 68 + n * 16 + fq * 4) = acc[n]; acc[n] = (f32x4){0.f, 0.f, 0.f, 0.f}; }
            LBAR();
            if (tid < 256) {
                const int r = tid >> 4, c4 = (tid & 15) * 4; f32x4 v = (f32x4){0.f, 0.f, 0.f, 0.f};
#pragma unroll
                for (int w = 0; w < 8; ++w) v += *(const LAS f32x4*)(red + (w * 16 + r) * 68 + c4);
                const int lrow = rb * 16 + r, row = trow(lrow); const RowInfo ri = E.rowinfo(row, lrow, 0, lds);
                float s1 = 0.f, s2 = 0.f; E.apply(ri, cie, row, cb * 64 + c4, v, pve, s1, s2);
                if (Epi::STATS) {
#pragma unroll
                    for (int o = 1; o < 16; o <<= 1) { s1 += __shfl_xor(s1, o); s2 += __shfl_xor(s2, o); }
                    if ((tid & 15) == 0) *(f32x2*)(E.stat_out + ((size_t)row * 16 + cb) * 2) = (f32x2){s1, s2};
                }
            }
            LBAR();
        }
        if (!more) break;
        u = un; c = cn;
    }
#undef T_LOAD
}
template <class Epi>
__device__ __forceinline__ void gemm_tail16(LAS unsigned char* lds, const bf16_t* Ag, const bf16_t* Btg, const int K, const Epi& E) {
    const int tid = tidx(), wid = tid >> 6, lane = tid & 63, fr = lane & 15, fq = lane >> 4;
    LAS float* red = (LAS float*)lds;
    const int ks = K / 8, nch = ks / 128;
    bool first = true;
    for (int u = blockIdx.x; u < 256; u += gridDim.x) {
        const int rb = u & 3, cb = u >> 2;
        ColInfo cie; cie.a = (f32x4){0.f, 0.f, 0.f, 0.f}; cie.b = cie.a; f32x4 pve = (f32x4){0.f, 0.f, 0.f, 0.f};
        if (tid < 64) { const int ecol = cb * 16 + (tid & 3) * 4; cie = E.colinfo(ecol); pve = E.preload(trow(rb * 16 + (tid >> 2)), ecol); }
        const bf16_t* ap = Ag + (size_t)trow(rb * 16 + fr) * K + wid * ks + fq * 8;
        const bf16_t* bp = Btg + (size_t)(cb * 16 + fr) * K + wid * ks + fq * 8;
        bf16x8 af[4], bf[4];
#pragma unroll
        for (int s_ = 0; s_ < 4; ++s_) { af[s_] = *(const bf16x8*)(ap + s_ * 32); bf[s_] = *(const bf16x8*)(bp + s_ * 32); }
        if (first) { E.prep(64, 0, lds); first = false; }
        f32x4 acc = (f32x4){0.f, 0.f, 0.f, 0.f};
        for (int c = 0; c < nch; ++c) {
            bf16x8 ca[4], cbf[4];
#pragma unroll
            for (int s_ = 0; s_ < 4; ++s_) { ca[s_] = af[s_]; cbf[s_] = bf[s_]; }
            if (c + 1 < nch) {
#pragma unroll
                for (int s_ = 0; s_ < 4; ++s_) { af[s_] = *(const bf16x8*)(ap + (c + 1) * 128 + s_ * 32); bf[s_] = *(const bf16x8*)(bp + (c + 1) * 128 + s_ * 32); } }
#pragma unroll
            for (int s_ = 0; s_ < 4; ++s_) acc = MFMA16(cbf[s_], ca[s_], acc);
        }
        *(LAS f32x4*)(red + (wid * 16 + fr) * 20 + fq * 4) = acc;
        LBAR();
        if (tid < 64) {
            const int r = tid >> 2, c4 = (tid & 3) * 4; f32x4 v = (f32x4){0.f, 0.f, 0.f, 0.f};
#pragma unroll
            for (int w = 0; w < 8; ++w) v += *(const LAS f32x4*)(red + (w * 16 + r) * 20 + c4);
            const int lrow = rb * 16 + r, row = trow(lrow); const RowInfo ri = E.rowinfo(row, lrow, 0, lds);
            float s1 = 0.f, s2 = 0.f; E.apply(ri, cie, row, cb * 16 + c4, v, pve, s1, s2);
            s1 += __shfl_xor(s1, 1); s1 += __shfl_xor(s1, 2); s2 += __shfl_xor(s2, 1); s2 += __shfl_xor(s2, 2);
            if ((tid & 3) == 0) { float* sp = E.stat_out + ((size_t)row * 16 + (cb >> 2)) * 2; atomicAdd(sp, s1); atomicAdd(sp + 1, s2); }
        }
        LBAR();
    }
}
__device__ __forceinline__ void zero_tail_stats(float* stat) {
    if (blockIdx.x == 0) for (int i = tidx(); i < 64 * 32; i += NTHR) stat[(size_t)trow(i >> 5) * 32 + (i & 31)] = 0.f;
}
__device__ __forceinline__ void dt_units(LAS unsigned char* lds, const bf16_t* xb, const bf16_t* WinT, const float* stat, const float* c1, const float* c2, float* dtbuf, int fold, bf16_t* proj, const int ufirst, const int ustride, const int uend) {
    const int tid = tidx(), wid = tid >> 6, lane = tid & 63, fr = lane & 15, fq = lane >> 4, rb4 = wid & 3, kh = wid >> 2;
    LAS float* red = (LAS float*)lds;
    for (int u = ufirst; u < uend; u += ustride) {
        if (u % NCHB == 0) {
            for (int i = tid; i < PADR * (NPROJ / 8); i += NTHR) { const int r = i / (NPROJ / 8), c8 = (i - r * (NPROJ / 8)) * 8; *(u32x4*)(proj + ((size_t)u * 64 + r) * NPROJ + c8) = (u32x4){0u, 0u, 0u, 0u}; }
        }
        const bf16_t* ap = xb + (size_t)(u * 64 + rb4 * 16 + fr) * 1024 + kh * 512 + fq * 8;
        const bf16_t* bp = WinT + (size_t)(NPROJ + fr) * 1024 + kh * 512 + fq * 8;
        f32x4 acc = (f32x4){0.f, 0.f, 0.f, 0.f};
        { bf16x8 af[16], bf[16];
#pragma unroll
            for (int s = 0; s < 16; ++s) { af[s] = *(const bf16x8*)(ap + s * 32); bf[s] = *(const bf16x8*)(bp + s * 32); }
#pragma unroll
            for (int s = 0; s < 16; ++s) acc = MFMA16(bf[s], af[s], acc);
        }
        *(LAS f32x4*)(red + (kh * 64 + rb4 * 16 + fr) * 20 + fq * 4) = acc;
        LBAR();
        if (tid < 128) {
            const int r = tid >> 1, c4 = (tid & 1) * 4; const int row = u * 64 + r;
            f32x4 v = *(const LAS f32x4*)(red + r * 20 + c4) + *(const LAS f32x4*)(red + (64 + r) * 20 + c4);
            if (fold) {
                const f32x4* sp = (const f32x4*)(stat + (size_t)row * 32); float s1 = 0.f, s2 = 0.f;
#pragma unroll
                for (int q = 0; q < 8; ++q) { const f32x4 t = sp[q]; s1 += t[0] + t[2]; s2 += t[1] + t[3]; }
                const float mu = s1 * (1.0f / 1024.0f), var = fmaxf(s2 * (1.0f / 1024.0f) - mu * mu, 0.f), rstd = __builtin_amdgcn_rsqf(var + LN_EPS);
                const f32x4 k1 = *(const f32x4*)(c1 + NPROJ + c4), k2 = *(const f32x4*)(c2 + NPROJ + c4); v = (v - k1 * mu) * rstd + k2;
            }
            if ((row % LP) < PADR) v = (f32x4){-1e30f, -1e30f, -1e30f, -1e30f};
            if (c4 == 0) *(f32x4*)(dtbuf + (size_t)row * 8) = v; else *(f32x2*)(dtbuf + (size_t)row * 8 + 4) = (f32x2){v[0], v[1]};
        }
        LBAR();
    }
}

typedef unsigned short u16x4_t __attribute__((ext_vector_type(4)));
__device__ __forceinline__ bf16x8 tr_frag(unsigned a0, unsigned a1) {
    u16x4_t x, y;
    asm volatile("ds_read_b64_tr_b16 %0, %2\n\tds_read_b64_tr_b16 %1, %3\n\ts_waitcnt lgkmcnt(0)" : "=&v"(x), "=&v"(y) : "v"(a0), "v"(a1) : "memory");
    bf16x8 r; r[0] = (short)x[0]; r[1] = (short)x[1]; r[2] = (short)x[2]; r[3] = (short)x[3]; r[4] = (short)y[0]; r[5] = (short)y[1]; r[6] = (short)y[2]; r[7] = (short)y[3];
    return r;
}
__device__ __forceinline__ void hgrn_gates(const float* z, const float* lb, float* lf, float* kk) {
#pragma unroll
    for (int j = 0; j < 8; ++j) { const float sp = __builtin_amdgcn_rcpf(1.0f + __expf(-z[j])), sn = 1.0f - sp; const float f = lb[j] + (1.0f - lb[j]) * sp; lf[j] = __builtin_amdgcn_logf(f); kk[j] = (1.0f - lb[j]) * sn; }
}
__device__ __forceinline__ void cumsum64(LAS float* Gf, LAS float* seg) {
    const int tid = tidx(), k = tid & 63, sg = tid >> 6;
    float run = 0.f;
#pragma unroll
    for (int r = 0; r < 8; ++r) { run += Gf[(sg * 8 + r) * 65 + k]; Gf[(sg * 8 + r) * 65 + k] = run; }
    seg[sg * 64 + k] = run;
    LBAR();
    float pre = 0.f;
    for (int s = 0; s < sg; ++s) pre += seg[s * 64 + k];
#pragma unroll
    for (int r = 0; r < 8; ++r) Gf[(sg * 8 + r) * 65 + k] += pre;
    LBAR();
}

struct HgRaw { u32x4 q, f, i; f32x4 lb0, lb1; };
template <int WHICH>
__device__ __forceinline__ HgRaw hg_load(KP& P_, int l, int u, int tid) {
    const bf16_t* proj = (const bf16_t*)(p.ws + WS_PROJ);
    const int idx = u - 780, bc = idx / 6, h = idx - bc * 6, t = tid >> 3, k0 = (tid & 7) * 8; const size_t row = (size_t)bc * 64 + t;
    HgRaw r; r.q = (u32x4){0u, 0u, 0u, 0u};
    if (WHICH) r.q = *(const u32x4*)(proj + row * NPROJ + h * 64 + k0);
    r.f = *(const u32x4*)(proj + row * NPROJ + C_F + h * 64 + k0);
    r.i = *(const u32x4*)(proj + row * NPROJ + C_I + h * 64 + k0);
    const float* lbv = (const float*)(p.ws + TBL(T_LB, l)) + h * 64 + k0; r.lb0 = *(const f32x4*)lbv; r.lb1 = *(const f32x4*)(lbv + 4);
    return r;
}
__device__ __forceinline__ void hgrn_a_unit(LAS unsigned char* lds, KP& P_, int l, int bc, int h, const HgRaw& in) {
    LAS float* Gf = (LAS float*)lds; LAS float* seg = (LAS float*)(lds + 16640);
    LAS bf16_t* KT = (LAS bf16_t*)(lds + 18688); LAS bf16_t* VT = (LAS bf16_t*)(lds + 27904);
    const bf16_t* proj = (const bf16_t*)(p.ws + WS_PROJ); const float* lbv = (const float*)(p.ws + TBL(T_LB, l));
    const int tid = tidx(), t = tid >> 3, k0 = (tid & 7) * 8; const size_t row = (size_t)bc * 64 + t;
    float z[8], iv[8], lf[8], kk[8], lb[8];
    unpack8(in.f, z);
    const u32x4 iraw = in.i;
#pragma unroll
    for (int j = 0; j < 4; ++j) { lb[j] = in.lb0[j]; lb[4 + j] = in.lb1[j]; }
    hgrn_gates(z, lb, lf, kk);
    {
#pragma unroll
      for (int j = 0; j < 8; ++j) Gf[t * 65 + k0 + j] = lf[j];
      *(LAS u32x4*)(VT + t * 72 + k0) = iraw; }
    (void)iv;
    LBAR();
    cumsum64(Gf, seg);
    { float kd[8];
#pragma unroll
      for (int j = 0; j < 8; ++j) { const float G = Gf[t * 65 + k0 + j], Gl = Gf[63 * 65 + k0 + j]; kd[j] = kk[j] * __builtin_amdgcn_exp2f(Gl - G); }
      if (t == 63) { f32x4 d0, d1;
#pragma unroll
          for (int j = 0; j < 4; ++j) { d0[j] = __builtin_amdgcn_exp2f(Gf[63 * 65 + k0 + j]); d1[j] = __builtin_amdgcn_exp2f(Gf[63 * 65 + k0 + 4 + j]); }
          float* dp = (float*)(p.ws + WS_DECH) + ((size_t)bc * 6 + h) * 64 + k0; *(f32x4*)dp = d0; *(f32x4*)(dp + 4) = d1; }
      *(LAS u32x4*)(KT + t * 72 + k0) = pack8(kd); }
    LBAR();
    { const int wid = tid >> 6, lane = tid & 63, fr = lane & 15, fq = lane >> 4, kt = wid >> 1;
      bf16_t* sth = (bf16_t*)(p.ws + WS_STH) + ((size_t)bc * 6 + h) * 4096;
#pragma unroll
      for (int q = 0; q < 2; ++q) { const int vt = (wid & 1) * 2 + q; f32x4 acc = (f32x4){0.f, 0.f, 0.f, 0.f};
#pragma unroll
          for (int ks = 0; ks < 2; ++ks) { const unsigned ro = (unsigned)((32 * ks + 8 * fq + (fr >> 2)) * 144 + 8 * (fr & 3));
              const unsigned ka = (unsigned)(size_t)KT + ro + 32u * kt, va = (unsigned)(size_t)VT + ro + 32u * vt;
              const bf16x8 a = tr_frag(ka, ka + 576u), b = tr_frag(va, va + 576u); acc = MFMA16(a, b, acc); }
          *(u32x2*)(sth + (size_t)(vt * 16 + fr) * 64 + kt * 16 + fq * 4) = pack4(acc); } }
    LBAR();
}

__device__ __forceinline__ void hgrn_c_unit(LAS unsigned char* lds, KP& P_, int l, int bc, int h, const HgRaw& in) {
    LAS float* Gf = (LAS float*)lds; LAS float* seg = (LAS float*)(lds + 16640);
    LAS bf16_t* QP = (LAS bf16_t*)(lds + 18688); LAS bf16_t* QPP = (LAS bf16_t*)(lds + 27904); LAS bf16_t* KP = (LAS bf16_t*)(lds + 37120);
    LAS bf16_t* VT = (LAS bf16_t*)(lds + 46336); LAS bf16_t* PM = (LAS bf16_t*)(lds + 55552); LAS float* ss = (LAS float*)(lds + 64768);
    const bf16_t* proj = (const bf16_t*)(p.ws + WS_PROJ); const float* lbv = (const float*)(p.ws + TBL(T_LB, l));
    const int tid = tidx(), t = tid >> 3, k0 = (tid & 7) * 8; const size_t row = (size_t)bc * 64 + t;
    const int wid = tid >> 6, lane = tid & 63, fr = lane & 15, fq = lane >> 4;
    float z[8], q[8], lf[8], kk[8], lb[8];
    const int tt2 = wid & 3, vh = wid >> 2;
    bf16x8 sf[2][2]; u32x2 graw[2];
    { const bf16_t* sth = (const bf16_t*)(p.ws + WS_STH) + ((size_t)bc * 6 + h) * 4096;
#pragma unroll
      for (int qq = 0; qq < 2; ++qq) { const int vt = vh * 2 + qq;
#pragma unroll
          for (int ks = 0; ks < 2; ++ks) sf[qq][ks] = *(const bf16x8*)(sth + (size_t)(vt * 16 + fr) * 64 + ks * 32 + fq * 8);
          graw[qq] = *(const u32x2*)(proj + ((size_t)bc * 64 + tt2 * 16 + fr) * NPROJ + C_G + h * 64 + vt * 16 + fq * 4); } }
    f32x4 nwv[2];
#pragma unroll
    for (int qq = 0; qq < 2; ++qq) nwv[qq] = *(const f32x4*)(p.in[4] + l * 64 + (vh * 2 + qq) * 16 + fq * 4);
    unpack8(in.q, q);
    unpack8(in.f, z);
    const u32x4 iraw = in.i;
#pragma unroll
    for (int j = 0; j < 8; ++j) { lb[j] = j < 4 ? in.lb0[j & 3] : in.lb1[j & 3]; q[j] = siluf_(q[j]); }
    hgrn_gates(z, lb, lf, kk);
    {
#pragma unroll
      for (int j = 0; j < 8; ++j) Gf[t * 65 + k0 + j] = lf[j];
      *(LAS u32x4*)(VT + t * 72 + k0) = iraw; }
    LBAR();
    cumsum64(Gf, seg);
    { float a[8], b[8], c[8];
#pragma unroll
      for (int j = 0; j < 8; ++j) { const float G = Gf[t * 65 + k0 + j], R = Gf[31 * 65 + k0 + j]; a[j] = q[j] * __builtin_amdgcn_exp2f(G - R); b[j] = q[j] * __builtin_amdgcn_exp2f(G); c[j] = kk[j] * __builtin_amdgcn_exp2f(R - G); }
      *(LAS u32x4*)(QP + t * 72 + k0) = pack8(a); *(LAS u32x4*)(QPP + t * 72 + k0) = pack8(b); *(LAS u32x4*)(KP + t * 72 + k0) = pack8(c); }
    LBAR();
    {
        const int tt = wid >> 1;
#pragma unroll
        for (int qq = 0; qq < 2; ++qq) { const int st = (wid & 1) * 2 + qq; f32x4 acc = (f32x4){0.f, 0.f, 0.f, 0.f};
            if (st <= tt) {
#pragma unroll
                for (int ks = 0; ks < 2; ++ks) { const bf16x8 a = *(const LAS bf16x8*)(KP + (st * 16 + fr) * 72 + ks * 32 + fq * 8), b = *(const LAS bf16x8*)(QP + (tt * 16 + fr) * 72 + ks * 32 + fq * 8); acc = MFMA16(a, b, acc); }
                const int tq = tt * 16 + fr;
#pragma unroll
                for (int j = 0; j < 4; ++j) if (st * 16 + fq * 4 + j > tq) acc[j] = 0.f;
            }
            *(LAS u32x2*)(PM + (tt * 16 + fr) * 72 + st * 16 + fq * 4) = pack4(acc); }
    }
    LBAR();
    const int tt = tt2;
    f32x4 o[2];
    { float ssq = 0.f;
#pragma unroll
      for (int qq = 0; qq < 2; ++qq) { const int vt = vh * 2 + qq; f32x4 acc = (f32x4){0.f, 0.f, 0.f, 0.f};
#pragma unroll
          for (int ks = 0; ks < 2; ++ks) { const unsigned va = (unsigned)(size_t)VT + (unsigned)((32 * ks + 8 * fq + (fr >> 2)) * 144 + 8 * (fr & 3)) + 32u * vt;
              const bf16x8 a = tr_frag(va, va + 576u), b = *(const LAS bf16x8*)(PM + (tt * 16 + fr) * 72 + ks * 32 + fq * 8); acc = MFMA16(a, b, acc); }
#pragma unroll
          for (int ks = 0; ks < 2; ++ks) { const bf16x8 b = *(const LAS bf16x8*)(QPP + (tt * 16 + fr) * 72 + ks * 32 + fq * 8); acc = MFMA16(sf[qq][ks], b, acc); }
          o[qq] = acc; ssq += (acc[0] * acc[0] + acc[1] * acc[1]) + (acc[2] * acc[2] + acc[3] * acc[3]); }
      ssq += __shfl_xor(ssq, 16); ssq += __shfl_xor(ssq, 32);
      if (fq == 0) ss[(tt * 16 + fr) * 2 + vh] = ssq; }
    LBAR();
    { const int tq = tt * 16 + fr; const float rinv = __builtin_amdgcn_rsqf((ss[tq * 2] + ss[tq * 2 + 1]) * (1.0f / 64.0f) + RMS_EPS);
      const size_t orow = (size_t)bc * 64 + tq; bf16_t* mixed = (bf16_t*)(p.ws + WS_MIXED); const float* nw = p.in[4] + l * 64;
#pragma unroll
      for (int qq = 0; qq < 2; ++qq) { const int v = (vh * 2 + qq) * 16 + fq * 4;
          const float gv[4] = {bflo(graw[qq].x), bfhi(graw[qq].x), bflo(graw[qq].y), bfhi(graw[qq].y)}; f32x4 r;
#pragma unroll
          for (int j = 0; j < 4; ++j) r[j] = o[qq][j] * rinv * nwv[qq][j] * siluf_(gv[j]);
          *(u32x2*)(mixed + orow * DM + h * 64 + v) = pack4(r); } }
    LBAR();
}

__device__ __forceinline__ void m2_dt(KP& P_, int l, int bc, int grp, LAS float* dtl, LAS float* acs, LAS float* wl, bool write_dec) {
    const int tid = tidx(), wid = tid >> 6, lane = tid & 63;
    if (wid < 3) {
        const int head = grp * 3 + wid; const float draw = ((const float*)(p.ws + WS_DT))[((size_t)bc * 64 + lane) * 8 + head];
        const float dt = draw < -1e29f ? 0.f : softplusf_(draw + p.in[7][l * 6 + head]);
        const float a = -expf(p.in[8][l * 6 + head]); float x = dt * a;
#pragma unroll
        for (int off = 1; off < 64; off <<= 1) { const float v = __shfl_up(x, off); if (lane >= off) x += v; }
        const float tot = __shfl(x, 63);
        dtl[wid * 64 + lane] = dt; acs[wid * 64 + lane] = x; wl[wid * 64 + lane] = dt * __expf(tot - x);
        if (write_dec && lane == 63) ((float*)(p.ws + WS_DECM))[(size_t)bc * 6 + head] = __expf(tot);
    }
}
__device__ __forceinline__ void m2_load_cw(LAS float* CW, KP& P_, int l, int grp, int nch) {
    const float* cw = p.in[5] + (size_t)l * 4 * 896; const float* cb = p.in[6] + (size_t)l * 896;
    float v[5]; const int t0 = tidx();
#pragma unroll
    for (int q = 0; q < 5; ++q) { const int i = t0 + q * NTHR; v[q] = 0.f;
        if (i < 5 * nch) { const int tap = i / nch, c = i - tap * nch;
            const int gch = c < 192 ? grp * 192 + c : (c < 320 ? 384 + grp * 128 + (c - 192) : 640 + grp * 128 + (c - 320));
            v[q] = tap < 4 ? cw[tap * 896 + gch] : cb[gch]; } }
#pragma unroll
    for (int q = 0; q < 5; ++q) { const int i = t0 + q * NTHR; if (i < 5 * nch) { const int tap = i / nch, c = i - tap * nch; CW[tap * 448 + c] = v[q]; } }
}
__device__ __forceinline__ int m2_pcol(int grp, int cgi) { return cgi < 24 ? C_X + grp * 192 + cgi * 8 : (cgi < 40 ? C_B + grp * 128 + (cgi - 24) * 8 : C_C + grp * 128 + (cgi - 40) * 8); }
__device__ __forceinline__ void m2_conv_load(KP& P_, int bc, int t, int pcol, u32x4* raw) {
    const bf16_t* proj = (const bf16_t*)(p.ws + WS_PROJ);
#pragma unroll
    for (int tap = 0; tap < 4; ++tap) { const int gr = max(bc * 64 + t - 3 + tap, 0); raw[tap] = *(const u32x4*)(proj + (size_t)gr * NPROJ + pcol); }
}
__device__ __forceinline__ void m2_conv_compute(const LAS float* CW, int c0, const u32x4* raw, float* y) {
    { const f32x4 b0 = *(const LAS f32x4*)(CW + 4 * 448 + c0), b1 = *(const LAS f32x4*)(CW + 4 * 448 + c0 + 4);
#pragma unroll
      for (int j = 0; j < 4; ++j) { y[j] = b0[j]; y[4 + j] = b1[j]; } }
#pragma unroll
    for (int tap = 0; tap < 4; ++tap) { float x[8]; unpack8(raw[tap], x); const f32x4 w0 = *(const LAS f32x4*)(CW + tap * 448 + c0), w1 = *(const LAS f32x4*)(CW + tap * 448 + c0 + 4);
#pragma unroll
        for (int j = 0; j < 4; ++j) { y[j] += w0[j] * x[j]; y[4 + j] += w1[j] * x[4 + j]; } }
#pragma unroll
    for (int j = 0; j < 8; ++j) y[j] = siluf_(y[j]);
}

__device__ void m2_a_unit(LAS unsigned char* lds, KP& P_, int l, int bc, int grp) {
    LAS bf16_t* XN = (LAS bf16_t*)lds;
    LAS bf16_t* BN = (LAS bf16_t*)(lds + 27648);
    LAS float* dtl = (LAS float*)(lds + 46080); LAS float* acs = (LAS float*)(lds + 46848); LAS float* wl = (LAS float*)(lds + 47616); LAS float* CW = (LAS float*)(lds + 48384);
    const int tid = tidx(), wid = tid >> 6, lane = tid & 63, fr = lane & 15, fq = lane >> 4;
    u32x4 raw[5][4];
    { int t = tid / 40, cgi = tid - t * 40;
#pragma unroll
      for (int it = 0; it < 5; ++it) { m2_conv_load(P_, bc, t, m2_pcol(grp, cgi), raw[it]); t += 12; cgi += 32; if (cgi >= 40) { cgi -= 40; ++t; } } }
    m2_dt(P_, l, bc, grp, dtl, acs, wl, true);
    m2_load_cw(CW, P_, l, grp, 320);
    LBAR();
    int t = tid / 40, cgi = tid - (tid / 40) * 40;
#pragma unroll
    for (int it = 0; it < 5; ++it) { float y[8];
        m2_conv_compute(CW, cgi * 8, raw[it], y);
        if (cgi < 24) { const float w = wl[(cgi >> 3) * 64 + t];
#pragma unroll
            for (int j = 0; j < 8; ++j) y[j] *= w;
            *(LAS u32x4*)(XN + t * 200 + cgi * 8) = pack8(y); }
        else *(LAS u32x4*)(BN + t * 136 + (cgi - 24) * 8) = pack8(y);
        t += 12; cgi += 32; if (cgi >= 40) { cgi -= 40; ++t; } }
    LBAR();
    { const int nt = wid; bf16x8 a[2];
      const unsigned xn_base = (unsigned)(size_t)XN, bn_base = (unsigned)(size_t)BN;
#pragma unroll
      for (int ks = 0; ks < 2; ++ks) { const unsigned ba = bn_base + (unsigned)((32 * ks + 8 * fq + (fr >> 2)) * 272 + 8 * (fr & 3)) + 32u * nt; a[ks] = tr_frag(ba, ba + 1088u); }
      bf16_t* stm = (bf16_t*)(p.ws + WS_STM);
      for (int pt = 0; pt < 12; ++pt) { f32x4 acc = (f32x4){0.f, 0.f, 0.f, 0.f};
#pragma unroll
          for (int ks = 0; ks < 2; ++ks) { const unsigned xa = xn_base + (unsigned)((32 * ks + 8 * fq + (fr >> 2)) * 400 + 8 * (fr & 3)) + 32u * pt; const bf16x8 b = tr_frag(xa, xa + 1600u); acc = MFMA16(a[ks], b, acc); }
          const int head = grp * 3 + (pt >> 2), pl = (pt & 3) * 16 + fr;
          *(u32x2*)(stm + (((size_t)bc * 6 + head) * 64 + pl) * 128 + nt * 16 + fq * 4) = pack4(acc); } }
    LBAR();
}

__device__ void m2_c_unit(LAS unsigned char* lds, KP& P_, int l, int bc, int grp) {
    LAS bf16_t* XN = (LAS bf16_t*)lds;
    LAS bf16_t* BM = (LAS bf16_t*)(lds + 27648); LAS bf16_t* CM = (LAS bf16_t*)(lds + 45056); LAS bf16_t* PH = (LAS bf16_t*)(lds + 62464);
    LAS float* dtl = (LAS float*)(lds + 90112); LAS float* acs = (LAS float*)(lds + 90880); LAS float* wl = (LAS float*)(lds + 91648); LAS float* ss = (LAS float*)(lds + 92416);
    LAS float* CW = (LAS float*)(lds + 92928);
    const bf16_t* proj = (const bf16_t*)(p.ws + WS_PROJ);
    const int tid = tidx(), wid = tid >> 6, lane = tid & 63, fr = lane & 15, fq = lane >> 4;
    {
        u32x4 raw[7][4];
        { int t = tid / 56, cgi = tid - t * 56;
#pragma unroll
          for (int it = 0; it < 7; ++it) { m2_conv_load(P_, bc, t, m2_pcol(grp, cgi), raw[it]); t += 9; cgi += 8; if (cgi >= 56) { cgi -= 56; ++t; } } }
        m2_dt(P_, l, bc, grp, dtl, acs, wl, false);
        m2_load_cw(CW, P_, l, grp, 448);
        LBAR();
        int t = tid / 56, cgi = tid - (tid / 56) * 56;
#pragma unroll
        for (int it = 0; it < 7; ++it) { float y[8];
            m2_conv_compute(CW, cgi * 8, raw[it], y);
            if (cgi < 24) *(LAS u32x4*)(XN + t * 200 + cgi * 8) = pack8(y);
            else if (cgi < 40) *(LAS u32x4*)(BM + t * 136 + (cgi - 24) * 8) = pack8(y);
            else *(LAS u32x4*)(CM + t * 136 + (cgi - 40) * 8) = pack8(y);
            t += 9; cgi += 8; if (cgi >= 56) { cgi -= 56; ++t; } }
    }
    LBAR();
    {
        const int tt = wid >> 1;
#pragma unroll
        for (int qq = 0; qq < 2; ++qq) { const int st = (wid & 1) * 2 + qq; f32x4 acc = (f32x4){0.f, 0.f, 0.f, 0.f};
            if (st <= tt) {
#pragma unroll
                for (int ks = 0; ks < 4; ++ks) { const bf16x8 a = *(const LAS bf16x8*)(BM + (st * 16 + fr) * 136 + ks * 32 + fq * 8), b = *(const LAS bf16x8*)(CM + (tt * 16 + fr) * 136 + ks * 32 + fq * 8); acc = MFMA16(a, b, acc); } }
            const int tq = tt * 16 + fr;
#pragma unroll
            for (int hh = 0; hh < 3; ++hh) { f32x4 r; const float at = acs[hh * 64 + tq];
#pragma unroll
                for (int j = 0; j < 4; ++j) { const int s = st * 16 + fq * 4 + j; r[j] = (s <= tq) ? acc[j] * __expf(at - acs[hh * 64 + s]) * dtl[hh * 64 + s] : 0.f; }
                *(LAS u32x2*)(PH + hh * 4608 + tq * 72 + st * 16 + fq * 4) = pack4(r); } }
    }
    LBAR();
    const int tt = wid & 3, ph = wid >> 2, tq = tt * 16 + fr; const size_t orow = (size_t)bc * 64 + tq;
    const unsigned xn_base = (unsigned)(size_t)XN;
    f32x4 yv[6], nwv[6];
#pragma unroll
    for (int i = 0; i < 6; ++i) nwv[i] = *(const f32x4*)(p.in[10] + l * 384 + grp * 192 + (ph * 6 + i) * 16 + fq * 4);
    { bf16x8 cf[4];
#pragma unroll
      for (int ks = 0; ks < 4; ++ks) cf[ks] = *(const LAS bf16x8*)(CM + tq * 136 + ks * 32 + fq * 8);
      const bf16_t* stm = (const bf16_t*)(p.ws + WS_STM); float ssq = 0.f;
      u32x2 zraw[6];
#pragma unroll
      for (int i = 0; i < 6; ++i) zraw[i] = *(const u32x2*)(proj + orow * NPROJ + C_Z + grp * 192 + (ph * 6 + i) * 16 + fq * 4);
      bf16x8 hf[4];
#pragma unroll
      for (int ks = 0; ks < 4; ++ks) hf[ks] = *(const bf16x8*)(stm + (((size_t)bc * 6 + grp * 3 + ((ph * 6) >> 2)) * 64 + ((ph * 6) & 3) * 16 + fr) * 128 + ks * 32 + fq * 8);
#pragma unroll
      for (int i = 0; i < 6; ++i) { const int pt = ph * 6 + i, hh = pt >> 2, head = grp * 3 + hh;
          f32x4 ad = (f32x4){0.f, 0.f, 0.f, 0.f}, ao = (f32x4){0.f, 0.f, 0.f, 0.f};
          bf16x8 hc[4];
#pragma unroll
          for (int ks = 0; ks < 4; ++ks) hc[ks] = hf[ks];
          if (i < 5) { const int pn = pt + 1;
#pragma unroll
              for (int ks = 0; ks < 4; ++ks) hf[ks] = *(const bf16x8*)(stm + (((size_t)bc * 6 + grp * 3 + (pn >> 2)) * 64 + (pn & 3) * 16 + fr) * 128 + ks * 32 + fq * 8); }
#pragma unroll
          for (int ks = 0; ks < 2; ++ks) { const unsigned ta = xn_base + (unsigned)((32 * ks + 8 * fq + (fr >> 2)) * 400 + (16 * pt + 4 * (fr & 3)) * 2);
              const bf16x8 a = tr_frag(ta, ta + 1600u), b = *(const LAS bf16x8*)(PH + hh * 4608 + tq * 72 + ks * 32 + fq * 8); ad = MFMA16(a, b, ad); }
#pragma unroll
          for (int ks = 0; ks < 4; ++ks) ao = MFMA16(hc[ks], cf[ks], ao);
          const float ea = __expf(acs[hh * 64 + tq]), dsk = p.in[9][l * 6 + head]; const int pch = pt * 16 + fq * 4;
          const float zv[4] = {bflo(zraw[i].x), bfhi(zraw[i].x), bflo(zraw[i].y), bfhi(zraw[i].y)};
          f32x4 y;
          const u32x2 xraw = *(const LAS u32x2*)(XN + tq * 200 + pch); const float xsv[4] = {bflo(xraw.x), bfhi(xraw.x), bflo(xraw.y), bfhi(xraw.y)};
#pragma unroll
          for (int j = 0; j < 4; ++j) { y[j] = (ad[j] + ea * ao[j] + dsk * xsv[j]) * siluf_(zv[j]); ssq += y[j] * y[j]; }
          yv[i] = y; }
      ssq += __shfl_xor(ssq, 16); ssq += __shfl_xor(ssq, 32);
      if (fq == 0) ss[tq * 2 + ph] = ssq; }
    LBAR();
    { const float rinv = __builtin_amdgcn_rsqf((ss[tq * 2] + ss[tq * 2 + 1]) * (1.0f / 192.0f) + RMS_EPS);
      bf16_t* mixed = (bf16_t*)(p.ws + WS_MIXED); const float* nw = p.in[10] + l * 384 + grp * 192;
#pragma unroll
      for (int i = 0; i < 6; ++i) { const int pch = (ph * 6 + i) * 16 + fq * 4; f32x4 r;
#pragma unroll
          for (int j = 0; j < 4; ++j) r[j] = yv[i][j] * rinv * nwv[i][j];
          *(u32x2*)(mixed + orow * DM + 384 + grp * 192 + pch) = pack4(r); } }
    LBAR();
}

__device__ __forceinline__ void s5_bu_block(const LAS bf16_t* UB, LAS bf16_t* XW, const bf16x8* bfrag, int blk, int g, int fr, int fq) {
    bf16x8 af = (bf16x8){0, 0, 0, 0, 0, 0, 0, 0};
    if (fq < 2) af = *(const LAS bf16x8*)(UB + (blk * 16 + fr) * 264 + g * 16 + fq * 8);
#pragma unroll
    for (int tile = 0; tile < 8; ++tile) { f32x4 acc = (f32x4){0.f, 0.f, 0.f, 0.f}; acc = MFMA16(bfrag[tile], af, acc);
        *(LAS u32x2*)(XW + fr * 136 + tile * 16 + fq * 4) = pack4(acc); }
    asm volatile("" ::: "memory");
}
__device__ __forceinline__ void s5_load_bfrag(KP& P_, int l, bf16x8* bfrag, int g, int fr, int fq) {
    const bf16_t* bbh = (const bf16_t*)(p.ws + TBL(T_S5BBH, l)) + (size_t)(g * 128 + fr) * 16 + (fq & 1) * 8;
#pragma unroll
    for (int tile = 0; tile < 8; ++tile) { bfrag[tile] = (bf16x8){0, 0, 0, 0, 0, 0, 0, 0}; if (fq < 2) bfrag[tile] = *(const bf16x8*)(bbh + tile * 256); }
}
__device__ __forceinline__ void s5_load_u(LAS bf16_t* UB, KP& P_, int bc) {
    const bf16_t* proj = (const bf16_t*)(p.ws + WS_PROJ);
    for (int it = 0; it < 4; ++it) { const int item = it * NTHR + tidx(), t = item >> 5, c8 = (item & 31) * 8;
        *(LAS u32x4*)(UB + t * 264 + c8) = *(const u32x4*)(proj + ((size_t)bc * 64 + t) * NPROJ + C_U + c8); }
}
__device__ void s5_a_unit(LAS unsigned char* lds, KP& P_, int l, int bc) {
    LAS bf16_t* UB = (LAS bf16_t*)lds; LAS bf16_t* XB = (LAS bf16_t*)(lds + 33792);
    const int tid = tidx(), wid = tid >> 6, lane = tid & 63, fr = lane & 15, fq = lane >> 4;
    s5_load_u(UB, P_, bc);
    LBAR();
    LAS bf16_t* XW = XB + wid * 2176;
    for (int gp = 0; gp < 2; ++gp) { const int g = gp * 8 + wid, n = lane;
        bf16x8 bfrag[8]; s5_load_bfrag(P_, l, bfrag, g, fr, fq);
        const f32x4 lam = *(const f32x4*)((const float*)(p.ws + TBL(T_S5LAM, l)) + (size_t)(g * 64 + n) * 4);
        float xr = 0.f, xi = 0.f;
        for (int blk = 0; blk < 4; ++blk) {
            s5_bu_block(UB, XW, bfrag, blk, g, fr, fq);
#pragma unroll
            for (int tl = 0; tl < 16; ++tl) { const unsigned w = *(const LAS unsigned*)(XW + tl * 136 + 2 * n);
                const float nr = lam[0] * xr - lam[1] * xi + bflo(w), ni = lam[0] * xi + lam[1] * xr + bfhi(w); xr = nr; xi = ni; }
            asm volatile("" ::: "memory");
        }
        *(f32x2*)((float*)(p.ws + WS_STS) + (((size_t)bc * 16 + g) * 64 + n) * 2) = (f32x2){xr, xi}; }
    LBAR();
}
__device__ void s5_c_unit(LAS unsigned char* lds, KP& P_, int l, int bc) {
    LAS bf16_t* UB = (LAS bf16_t*)lds; LAS bf16_t* XB = (LAS bf16_t*)(lds + 33792); LAS bf16_t* YG = (LAS bf16_t*)(lds + 68608);
    const int tid = tidx(), wid = tid >> 6, lane = tid & 63, fr = lane & 15, fq = lane >> 4;
    s5_load_u(UB, P_, bc);
    LBAR();
    LAS bf16_t* XW = XB + wid * 2176;
    for (int gp = 0; gp < 2; ++gp) { const int g = gp * 8 + wid, n = lane;
        bf16x8 bfrag[8]; s5_load_bfrag(P_, l, bfrag, g, fr, fq);
        const f32x4 lam = *(const f32x4*)((const float*)(p.ws + TBL(T_S5LAM, l)) + (size_t)(g * 64 + n) * 4);
        const f32x2 x0 = *(const f32x2*)((const float*)(p.ws + WS_STS) + (((size_t)bc * 16 + g) * 64 + n) * 2);
        float xr = x0.x, xi = x0.y;
        bf16x8 cf[4]; const bf16_t* cm = (const bf16_t*)(p.ws + TBL(T_S5C, l)) + (size_t)(g * 16 + fr) * 128;
#pragma unroll
        for (int ks = 0; ks < 4; ++ks) cf[ks] = *(const bf16x8*)(cm + ks * 32 + fq * 8);
        const float* dsk = p.in[18] + l * 256 + g * 16 + fq * 4;
        for (int blk = 0; blk < 4; ++blk) {
            s5_bu_block(UB, XW, bfrag, blk, g, fr, fq);
#pragma unroll
            for (int tl = 0; tl < 16; ++tl) { LAS unsigned* wp = (LAS unsigned*)(XW + tl * 136 + 2 * n); const unsigned w = *wp;
                const float nr = lam[0] * xr - lam[1] * xi + bflo(w), ni = lam[0] * xi + lam[1] * xr + bfhi(w); xr = nr; xi = ni; *wp = cvt_pk_bf16(xr, xi); }
            asm volatile("" ::: "memory");
            f32x4 acc = (f32x4){0.f, 0.f, 0.f, 0.f};
#pragma unroll
            for (int ks = 0; ks < 4; ++ks) { const bf16x8 b = *(const LAS bf16x8*)(XW + fr * 136 + ks * 32 + fq * 8); acc = MFMA16(cf[ks], b, acc); }
            const int t = blk * 16 + fr; const u32x2 uraw = *(const LAS u32x2*)(UB + t * 264 + g * 16 + fq * 4);
            const float uv[4] = {bflo(uraw.x), bfhi(uraw.x), bflo(uraw.y), bfhi(uraw.y)}; f32x4 y;
#pragma unroll
            for (int j = 0; j < 4; ++j) y[j] = gelu_tanh(acc[j] + dsk[j] * uv[j]);
            *(LAS u32x2*)(YG + t * 264 + g * 16 + fq * 4) = pack4(y);
            asm volatile("" ::: "memory");
        } }
    LBAR();
    {
        const int tt = wid & 3, jh = wid >> 2, tq = tt * 16 + fr; bf16x8 yf[8];
#pragma unroll
        for (int ks = 0; ks < 8; ++ks) yf[ks] = *(const LAS bf16x8*)(YG + tq * 264 + ks * 32 + fq * 8);
        const bf16_t* glut = (const bf16_t*)(p.ws + TBL(T_GLUT, l)); const float* gb = p.in[20] + l * 256; bf16_t* mixed = (bf16_t*)(p.ws + WS_MIXED);
        bf16x8 gn[8]; f32x4 gbv[8];
#pragma unroll
        for (int i = 0; i < 8; ++i) gbv[i] = *(const f32x4*)(gb + (jh * 8 + i) * 16 + fq * 4);
#pragma unroll
        for (int ks = 0; ks < 8; ++ks) gn[ks] = *(const bf16x8*)(glut + (size_t)(jh * 128 + fr) * 256 + ks * 32 + fq * 8);
#pragma unroll
        for (int i = 0; i < 8; ++i) { const int jt = jh * 8 + i; f32x4 acc = (f32x4){0.f, 0.f, 0.f, 0.f};
            bf16x8 gc[8];
#pragma unroll
            for (int ks = 0; ks < 8; ++ks) gc[ks] = gn[ks];
            if (i < 7) {
#pragma unroll
                for (int ks = 0; ks < 8; ++ks) gn[ks] = *(const bf16x8*)(glut + (size_t)((jt + 1) * 16 + fr) * 256 + ks * 32 + fq * 8); }
#pragma unroll
            for (int ks = 0; ks < 8; ++ks) acc = MFMA16(gc[ks], yf[ks], acc);
            const int jc = jt * 16 + fq * 4; const u32x2 yraw = *(const LAS u32x2*)(YG + tq * 264 + jc); const float yv[4] = {bflo(yraw.x), bfhi(yraw.x), bflo(yraw.y), bfhi(yraw.y)}; f32x4 r;
#pragma unroll
            for (int j = 0; j < 4; ++j) r[j] = yv[j] * sigmoidf_(acc[j] + gbv[i][j]);
            *(u32x2*)(mixed + ((size_t)bc * 64 + tq) * DM + 768 + jc) = pack4(r); }
    }
    LBAR();
}

constexpr int NMIXU = 260 + 520 + 1560;
constexpr size_t WS_CTR = WS_BAR + 14336;
template <int WHICH>
__device__ void phase_mix_dyn(LAS unsigned char* lds, KP& P0, int l0) {
    volatile LAS int* tick = (volatile LAS int*)(lds + LDS_BYTES - 32);
    const int tid0 = tidx();
    unsigned* ctr; { KPtr P_ = P0; ctr = (unsigned*)(p.ws + WS_CTR) + (l0 * 2 + WHICH) * 64; }
    int n1 = 0, n2 = 0;
    if (tid0 == 0) { n1 = (int)__hip_atomic_fetch_add(ctr, 1u, __ATOMIC_RELAXED, __HIP_MEMORY_SCOPE_AGENT); n2 = (int)__hip_atomic_fetch_add(ctr, 1u, __ATOMIC_RELAXED, __HIP_MEMORY_SCOPE_AGENT); }
    int u, un;
    for (;;) {
        if (tid0 == 0) { tick[0] = n1; tick[1] = n2; }
        LBAR();
        u = tick[0]; un = tick[1];
        if (u >= 780) break;
        if (tid0 == 0) { n1 = n2; n2 = (int)__hip_atomic_fetch_add(ctr, 1u, __ATOMIC_RELAXED, __HIP_MEMORY_SCOPE_AGENT); }
        KPtr P_ = P0; int l = l0; asm volatile("" : "+s"(P_.q), "+s"(l));
        if (WHICH == 0) { if (u < 520) m2_a_unit(lds, P_, l, u >> 1, u & 1); else s5_a_unit(lds, P_, l, u - 520); }
        else            { if (u < 520) m2_c_unit(lds, P_, l, u >> 1, u & 1); else s5_c_unit(lds, P_, l, u - 520); }
    }
    if (u >= NMIXU) return;
    HgRaw nxt; { KPtr P_ = P0; asm volatile("" : "+s"(P_.q)); nxt = hg_load<WHICH>(P_, l0, u, tid0); }
    for (;;) {
        if (tid0 == 0) { n1 = n2; n2 = (int)__hip_atomic_fetch_add(ctr, 1u, __ATOMIC_RELAXED, __HIP_MEMORY_SCOPE_AGENT); }
        KPtr P_ = P0; int l = l0; asm volatile("" : "+s"(P_.q), "+s"(l));
        const HgRaw cur = nxt;
        if (un < NMIXU) nxt = hg_load<WHICH>(P_, l, un, tid0);
        if (WHICH == 0) hgrn_a_unit(lds, P_, l, (u - 780) / 6, (u - 780) % 6, cur);
        else            hgrn_c_unit(lds, P_, l, (u - 780) / 6, (u - 780) % 6, cur);
        if (un >= NMIXU) break;
        if (tid0 == 0) { tick[0] = n1; tick[1] = n2; }
        LBAR();
        u = tick[0]; un = tick[1];
    }
}
__device__ void phase_mix_b(KP& P_, int l) {
    const int gt = blockIdx.x * NTHR + tidx(), GT = gridDim.x * NTHR;
    for (int e = gt; e < 24576 + 12288 + 4096; e += GT) {
        if (e < 24576) {
            const int n8 = e & 15, pp = (e >> 4) & 63, bh = e >> 10, head = bh % 6, b = bh / 6;
            bf16_t* base = (bf16_t*)(p.ws + WS_STM) + (((size_t)(b * NCHB) * 6 + head) * 64 + pp) * 128 + n8 * 8; const float* dec = (const float*)(p.ws + WS_DECM) + (size_t)(b * NCHB) * 6 + head;
            float s[8];
#pragma unroll
            for (int j = 0; j < 8; ++j) s[j] = 0.f;
            for (int cb = 0; cb < NCHB; cb += 13) { u32x4 uu[13]; float d[13];
#pragma unroll
                for (int i = 0; i < 13; ++i) { uu[i] = *(const u32x4*)(base + (size_t)(cb + i) * 6 * 8192); d[i] = dec[(cb + i) * 6]; }
#pragma unroll
                for (int i = 0; i < 13; ++i) { float uf[8]; unpack8(uu[i], uf); *(u32x4*)(base + (size_t)(cb + i) * 6 * 8192) = pack8(s);
#pragma unroll
                    for (int j = 0; j < 8; ++j) s[j] = d[i] * s[j] + uf[j]; } }
        } else if (e < 24576 + 12288) {
            const int e2 = e - 24576, k8 = e2 & 7, v = (e2 >> 3) & 63, bh = e2 >> 9, h = bh % 6, b = bh / 6;
            bf16_t* base = (bf16_t*)(p.ws + WS_STH) + (((size_t)(b * NCHB) * 6 + h) * 64 + v) * 64 + k8 * 8; const float* dec = (const float*)(p.ws + WS_DECH) + ((size_t)(b * NCHB) * 6 + h) * 64 + k8 * 8;
            float s[8];
#pragma unroll
            for (int j = 0; j < 8; ++j) s[j] = 0.f;
            for (int cb = 0; cb < NCHB; cb += 13) { u32x4 uu[13]; f32x4 d0[13], d1[13];
#pragma unroll
                for (int i = 0; i < 13; ++i) { uu[i] = *(const u32x4*)(base + (size_t)(cb + i) * 6 * 4096); const f32x4* dp = (const f32x4*)(dec + (size_t)(cb + i) * 384); d0[i] = dp[0]; d1[i] = dp[1]; }
#pragma unroll
                for (int i = 0; i < 13; ++i) { float uf[8]; unpack8(uu[i], uf); *(u32x4*)(base + (size_t)(cb + i) * 6 * 4096) = pack8(s);
#pragma unroll
                    for (int j = 0; j < 4; ++j) { s[j] = d0[i][j] * s[j] + uf[j]; s[4 + j] = d1[i][j] * s[4 + j] + uf[4 + j]; } } }
        } else {
            const int e2 = e - 24576 - 12288, gn = e2 & 1023, b = e2 >> 10;
            float* base = (float*)(p.ws + WS_STS) + ((size_t)(b * NCHB) * 1024 + gn) * 2; const f32x4 lam = *(const f32x4*)((const float*)(p.ws + TBL(T_S5LAM, l)) + (size_t)gn * 4);
            float xr = 0.f, xi = 0.f; asm volatile("" : "+v"(xr), "+v"(xi));
            for (int cb = 0; cb < NCHB; cb += 13) { f32x2 ev[13];
#pragma unroll
                for (int i = 0; i < 13; ++i) ev[i] = *(const f32x2*)(base + (size_t)(cb + i) * 2048);
#pragma unroll
                for (int i = 0; i < 13; ++i) { *(f32x2*)(base + (size_t)(cb + i) * 2048) = (f32x2){xr, xi};
                    const float nr = lam[2] * xr - lam[3] * xi + ev[i].x, ni = lam[2] * xi + lam[3] * xr + ev[i].y; xr = nr; xi = ni; } }
        }
    }
}

__device__ void phase_final(KP& P_) {
    const bf16_t* xb = (const bf16_t*)(p.ws + WS_PRE); const float* stat = (const float*)(p.ws + WS_STAT1);
    const float* g = p.in[26] + 3 * DM; const float* b = p.in[27] + 3 * DM;
    const int wid = tidx() >> 6, lane = tidx() & 63;
    for (int r = blockIdx.x * 8 + wid; r < NBATCH * SEQ; r += gridDim.x * 8) {
        const int bb = r / SEQ, t = r - bb * SEQ; const size_t row = (size_t)bb * LP + 64 + t;
        f32x2 sv = *(const f32x2*)(stat + (row * 16 + (lane & 15)) * 2); float s1 = sv.x, s2 = sv.y;
#pragma unroll
        for (int o = 1; o < 16; o <<= 1) { s1 += __shfl_xor(s1, o); s2 += __shfl_xor(s2, o); }
        const float mu = s1 * (1.0f / 1024.0f), var = fmaxf(s2 * (1.0f / 1024.0f) - mu * mu, 0.f), rstd = __builtin_amdgcn_rsqf(var + LN_EPS);
#pragma unroll
        for (int q = 0; q < 4; ++q) { const int c = q * 256 + lane * 4; const u32x2 w = *(const u32x2*)(xb + row * DM + c); const f32x4 v = (f32x4){bflo(w.x), bfhi(w.x), bflo(w.y), bfhi(w.y)};
            const f32x4 gg = *(const f32x4*)(g + c), bv = *(const f32x4*)(b + c);
            *(f32x4*)(p.out + (size_t)r * DM + c) = (v - mu) * rstd * gg + bv; }
    }
}

#define XB_TMO      128
#define XB_XCNT(j)  (256  + 64 * (j))
#define XB_XSUB(j)  (1280 + 64 * (j))
#define XB_XGEN(j)  (2304 + 64 * (j))
#define XB_TOP      3328
#define XB_TOPGEN   3392
#define XCD_BAR_WORDS 3456
#define XB_SPIN_CAP (1u << 20)
__device__ __forceinline__ unsigned xb_ld(unsigned* q)              { return __hip_atomic_load(q, __ATOMIC_RELAXED, __HIP_MEMORY_SCOPE_AGENT); }
__device__ __forceinline__ unsigned xb_add(unsigned* q, unsigned v) { return __hip_atomic_fetch_add(q, v, __ATOMIC_RELAXED, __HIP_MEMORY_SCOPE_AGENT); }
__device__ __forceinline__ unsigned xb_xcc_id() { return (unsigned)__builtin_amdgcn_s_getreg((3 << 11) | 20) & 0xFu; }
#define XB_SPIN(cond, bar) do { unsigned _sp = 0; while (cond) { __builtin_amdgcn_s_sleep(1); \
    if ((++_sp & 255u) == 0u) { if (xb_ld(&(bar)[XB_TMO])) break; if (_sp > XB_SPIN_CAP) { atomicAdd(&(bar)[XB_TMO], 1u); break; } } } } while (0)
struct XcdBarrier { unsigned* bar; unsigned x; volatile LAS unsigned* st; };
__device__ __forceinline__ XcdBarrier xcd_barrier_post(unsigned* bar, volatile LAS unsigned* st) {
    XcdBarrier b; b.bar = bar; b.x = xb_xcc_id(); b.st = st;
    if (threadIdx.x == 0) (void)xb_add(&bar[XB_XCNT(b.x)], 1u);
    return b;
}
__device__ __forceinline__ void xcd_barrier_complete(unsigned* bar, unsigned x, unsigned& nloc, unsigned& nx) {
    const unsigned G = gridDim.x * gridDim.y * gridDim.z;
    unsigned sum, cnt, mine, sp = 0u;
    for (;;) {
        sum = 0u; cnt = 0u; mine = 0u;
#pragma unroll
        for (unsigned j = 0; j < 16; ++j) { const unsigned c = xb_ld(&bar[XB_XCNT(j)]); sum += c; cnt += (c > 0u) ? 1u : 0u; mine = (j == x) ? c : mine; }
        if (sum == G) break;
        __builtin_amdgcn_s_sleep(1);
        if ((++sp & 255u) == 0u) { if (xb_ld(&bar[XB_TMO])) break; if (sp > XB_SPIN_CAP) { atomicAdd(&bar[XB_TMO], 1u); break; } }
    }
    nloc = mine > 0u ? mine : 1u; nx = cnt > 0u ? cnt : 1u;
}
__device__ __forceinline__ void xcd_barrier(const XcdBarrier& b) {
    asm volatile("s_waitcnt vmcnt(0)" ::: "memory");
    __syncthreads();
    if (threadIdx.x == 0) {
        unsigned* bar = b.bar;
        __builtin_amdgcn_s_waitcnt(0);
        unsigned nloc = b.st[0], nx = b.st[1];
        if (nloc == 0u) { xcd_barrier_complete(bar, b.x, nloc, nx); b.st[0] = nloc; b.st[1] = nx; }
        const unsigned old = xb_add(&bar[XB_XSUB(b.x)], 1u);
        const unsigned gen = old / nloc;
        if (old + 1u == (gen + 1u) * nloc) {
            __builtin_amdgcn_fence(__ATOMIC_RELEASE, "agent");
            asm volatile("s_waitcnt vmcnt(0)" ::: "memory");
            const unsigned og = xb_add(&bar[XB_TOP], 1u);
            const unsigned tg = og / nx;
            if (og + 1u == (tg + 1u) * nx) xb_add(&bar[XB_TOPGEN], 1u);
            else XB_SPIN(xb_ld(&bar[XB_TOPGEN]) == tg, bar);
            __builtin_amdgcn_fence(__ATOMIC_ACQUIRE, "agent");
            xb_add(&bar[XB_XGEN(b.x)], 1u);
            asm volatile("s_waitcnt vmcnt(0)" ::: "memory");
        } else {
            XB_SPIN(xb_ld(&bar[XB_XGEN(b.x)]) == gen, bar);
            __builtin_amdgcn_fence(__ATOMIC_ACQUIRE, "agent");
            asm volatile("s_waitcnt vmcnt(0)" ::: "memory");
        }
    }
    __syncthreads();
}

constexpr int NPHASE = 2 + 7 * DEPTH;
__device__ __forceinline__ void run_phase(LAS unsigned char* lds, KP& P_, int ph) {
    unsigned char* ob = (unsigned char*)p.out; unsigned char* ws = p.ws;
    if (ph == 0) { phase_init(P_); weights_units(lds, P_, -1, 0, (int)blockIdx.x, (int)gridDim.x); for (int lt = 0; lt < DEPTH; ++lt) tables_units(lds, P_, lt, 49 + 7 * lt); return; }
    if (ph == NPHASE - 1) { phase_final(P_); return; }
    int l = (ph - 1) / 7, k = (ph - 1) % 7; asm volatile("" : "+s"(l), "+s"(k));
    bf16_t* xb = (bf16_t*)(ws + WS_PRE);
    float* statA = (float*)(ws + WS_STAT0); float* statB = (float*)(ws + WS_STAT1);
    const bool tail_first = ((blockIdx.x >> 3) & 1) != 0;
    if (k == 0) { EpiInProj E{statB, (const float*)(ws + WS_C1IN), (const float*)(ws + WS_C2IN), (bf16_t*)(ws + WS_PROJ), (float*)(ws + WS_DT), p.in[7] + l * 6, nullptr, l > 0 ? 1 : 0};
        const int hrank = (((int)blockIdx.x >> 4) << 3) | ((int)blockIdx.x & 7), hsize = (int)gridDim.x >> 1;
        zero_tail_stats(statA);
        if (tail_first) weights_units(lds, P_, l, -1, hrank, hsize);
        gemm_phase(lds, xb, (const bf16_t*)(ob + OUT_WIN), 1024, 64, 12, E);
        if (!tail_first) {
            gemm_tail(lds, xb, (const bf16_t*)(ob + OUT_WIN), 1024, NPROJ, E, hrank, hsize);
            dt_units(lds, xb, (const bf16_t*)(ob + OUT_WIN), statB, (const float*)(ws + WS_C1IN), (const float*)(ws + WS_C2IN), (float*)(ws + WS_DT), l > 0 ? 1 : 0, (bf16_t*)(ws + WS_PROJ), hrank, hsize, 2 * hsize); }
        else if (2 * hsize + hrank < NCHT)
            dt_units(lds, xb, (const bf16_t*)(ob + OUT_WIN), statB, (const float*)(ws + WS_C1IN), (const float*)(ws + WS_C2IN), (float*)(ws + WS_DT), l > 0 ? 1 : 0, (bf16_t*)(ws + WS_PROJ), 2 * hsize + hrank, NCHT, NCHT);
    }
    else if (k == 1) { phase_mix_dyn<0>(lds, P_, l); }
    else if (k == 2) { phase_mix_b(P_, l); weights_units(lds, P_, -1, l < DEPTH - 1 ? l + 1 : -1, ((int)blockIdx.x - 80 + (int)gridDim.x) % (int)gridDim.x, (int)gridDim.x);
    }
    else if (k == 3) { phase_mix_dyn<1>(lds, P_, l); }
    else if (k == 4) { EpiResid E{statB, l > 0 ? p.in[26] + (size_t)(l - 1) * DM : nullptr, l > 0 ? p.in[27] + (size_t)(l - 1) * DM : nullptr, xb, statA, l > 0 ? 0 : 1};
        if (tail_first) gemm_tail16(lds, (const bf16_t*)(ws + WS_MIXED), (const bf16_t*)(ob + OUT_WOUT), 1024, E);
        gemm_phase(lds, (const bf16_t*)(ws + WS_MIXED), (const bf16_t*)(ob + OUT_WOUT), 1024, 64, 4, E);
        if (!tail_first) gemm_tail16(lds, (const bf16_t*)(ws + WS_MIXED), (const bf16_t*)(ob + OUT_WOUT), 1024, E); }
    else if (k == 5) { zero_tail_stats(statB);
        EpiMlpIn E{statA, (const float*)(ws + WS_C1MLP), (const float*)(ws + WS_C2MLP), (bf16_t*)(ws + WS_HID), nullptr};
        if (tail_first) gemm_tail(lds, xb, (const bf16_t*)(ob + OUT_W1), 1024, DFF, E, (int)blockIdx.x, (int)gridDim.x);
        gemm_phase(lds, xb, (const bf16_t*)(ob + OUT_W1), 1024, 64, 16, E);
        if (!tail_first) gemm_tail(lds, xb, (const bf16_t*)(ob + OUT_W1), 1024, DFF, E, (int)blockIdx.x, (int)gridDim.x);
    }
    else { EpiResid E{statA, p.in[22] + (size_t)l * DM, p.in[23] + (size_t)l * DM, xb, statB, 0};
        if (tail_first) gemm_tail16(lds, (const bf16_t*)(ws + WS_HID), (const bf16_t*)(ob + OUT_W2), 4096, E);
        gemm_phase(lds, (const bf16_t*)(ws + WS_HID), (const bf16_t*)(ob + OUT_W2), 4096, 64, 4, E);
        if (!tail_first) gemm_tail16(lds, (const bf16_t*)(ws + WS_HID), (const bf16_t*)(ob + OUT_W2), 4096, E); }
}

#undef p
__global__ void __launch_bounds__(NTHR, 2) mega(Params p) {
    extern __shared__ __attribute__((aligned(16))) unsigned char smem[];
    LAS unsigned char* lds = (LAS unsigned char*)smem;
    const int lo = p.ph_lo, hi = p.ph_hi;
    volatile LAS unsigned* st = (volatile LAS unsigned*)(lds + LDS_BYTES - 16);
    XcdBarrier bar; bar.bar = (unsigned*)(p.ws + WS_BAR); bar.x = 0; bar.st = st;
    if (hi - lo > 1) {
        if (threadIdx.x == 0) { st[0] = 0u; st[1] = 0u; }
        __syncthreads();
        bar = xcd_barrier_post((unsigned*)(p.ws + WS_BAR), st);
    }
    if (hi > 100000) cg::this_grid().sync();
    for (int ph = lo; ph < hi; ++ph) {
        KPtr kp; kp.q = (const __attribute__((address_space(4))) Params*)__builtin_amdgcn_kernarg_segment_ptr();
        asm volatile("" : "+s"(kp.q));
        run_phase(lds, kp, ph);
        if (ph + 1 < hi) xcd_barrier(bar);
    }
}

extern "C" void kernel_launch(void* const* d_in, const int* in_sizes, int n_in, void* d_out, int out_size, void* d_ws, size_t ws_size, hipStream_t stream) {
    static int grid = 0;
    if (grid == 0) {
        if (n_in != 28 || ws_size < WS_END || out_size != NBATCH * SEQ * DM) { fprintf(stderr, "kernel_launch: unexpected shapes (n_in %d, ws %zu, out %d)\n", n_in, ws_size, out_size); grid = -1; return; }
        if (hipFuncSetAttribute((const void*)mega, hipFuncAttributeMaxDynamicSharedMemorySize, LDS_BYTES) != hipSuccess) { fprintf(stderr, "kernel_launch: hipFuncSetAttribute failed\n"); grid = -1; return; }
        int dev = 0, cus = 0, per_cu = 0; hipGetDevice(&dev); hipDeviceGetAttribute(&cus, hipDeviceAttributeMultiprocessorCount, dev);
        hipOccupancyMaxActiveBlocksPerMultiprocessor(&per_cu, (const void*)mega, NTHR, LDS_BYTES);
        if (per_cu < 1) { fprintf(stderr, "kernel_launch: occupancy query says %d blocks per CU\n", per_cu); per_cu = 1; }
        grid = cus * 1;
    }
    if (grid < 0) return;
    Params p{};
    for (int i = 0; i < 28; ++i) p.in[i] = (const float*)d_in[i];
    p.out = (float*)d_out; p.ws = (unsigned char*)d_ws;
#if COOP
    if (hipMemsetAsync((char*)d_ws + WS_BAR, 0, 16384, stream) != hipSuccess) { fprintf(stderr, "kernel_launch: memset failed\n"); return; }
    p.ph_lo = 0; p.ph_hi = NPHASE;
    void* args[] = {&p};
    hipError_t e = hipLaunchCooperativeKernel((const void*)mega, dim3(grid), dim3(NTHR), args, LDS_BYTES, stream);
    if (e != hipSuccess) fprintf(stderr, "cooperative launch failed: %s (grid %d)\n", hipGetErrorString(e), grid);
#else
    for (int ph = 0; ph < NPHASE; ++ph) { p.ph_lo = ph; p.ph_hi = ph + 1; hipLaunchKernelGGL(mega, dim3(grid), dim3(NTHR), LDS_BYTES, stream, p); }
#endif
}
```

```cpp
#include <hip/hip_runtime.h>
#include <hip/hip_cooperative_groups.h>
#include <cstdio>
namespace cg = cooperative_groups;

#ifndef COOP
#define COOP 1
#endif

#define LAS __attribute__((address_space(3)))
typedef unsigned short bf16_t;
typedef short bf16x8 __attribute__((ext_vector_type(8)));
typedef float f32x4 __attribute__((ext_vector_type(4)));
typedef float f32x2 __attribute__((ext_vector_type(2)));
typedef unsigned u32x4 __attribute__((ext_vector_type(4)));
typedef unsigned u32x2 __attribute__((ext_vector_type(2)));

constexpr int DM = 1024, NBATCH = 4, SEQ = 4096, DEPTH = 4;
constexpr int LP = 4160, MR = 16640, NCHB = 65, NCHT = 260, PADR = 48;
constexpr int NPROJ = 3072, NINP = 3328, DFF = 4096, DIN = 3078;
constexpr int C_F = 384, C_I = 768, C_G = 1152, C_Z = 1536, C_X = 1920, C_B = 2304, C_C = 2560, C_U = 2816;
constexpr float ALPHA = 1.681792830507429f;
constexpr float LN_EPS = 1e-5f, RMS_EPS = 1e-6f;
constexpr int NTHR = 512;
constexpr int LDS_BYTES = 147456;
constexpr int RS_OFF = 131072;

constexpr size_t WS_PROJ = 0, WS_HID = 0;
constexpr size_t WS_MIXED = 102236160;
constexpr size_t WS_PRE = 136314880;
constexpr size_t WS_STH = 204472320;
constexpr size_t WS_STM = 217251840;
constexpr size_t WS_STS = 242810880;
constexpr size_t WS_DECH = 244940800;
constexpr size_t WS_DECM = 245340160;
constexpr size_t WS_DT = 245348352;
constexpr size_t WS_STAT0 = 245880832;
constexpr size_t WS_STAT1 = 248010752;
constexpr size_t WS_C1IN = 250140672;
constexpr size_t WS_C2IN = WS_C1IN + 13312;
constexpr size_t WS_C1MLP = WS_C2IN + 13312;
constexpr size_t WS_C2MLP = WS_C1MLP + 16384;
constexpr size_t WS_LB = WS_C2MLP + 16384;
constexpr size_t WS_S5LAM = WS_LB + 2048;
constexpr size_t WS_S5BB = WS_S5LAM + 16384;
constexpr size_t WS_S5C = WS_S5BB + 131072;
constexpr size_t WS_GLUT = WS_S5C + 65536;
constexpr size_t WS_BAR = WS_GLUT + 131072;
constexpr size_t WS_S5BBH = WS_BAR + 16384;
constexpr size_t WS_TBL = WS_S5BBH + 65536;
constexpr size_t T_LB = 0, T_S5LAM = 2048, T_S5BBH = 18432, T_S5C = 83968, T_GLUT = 149504, TBL_STRIDE = 280576;
#define TBL(off, l) (WS_TBL + (size_t)(l) * TBL_STRIDE + (off))
constexpr size_t WS_END = WS_TBL + 4 * TBL_STRIDE;
constexpr size_t OUT_XB = 0, OUT_WIN = 34078720, OUT_WOUT = 40894464, OUT_W1 = 42991616, OUT_W2 = 51380224;

struct Params { const float* in[28]; float* out; unsigned char* ws; int ph_lo, ph_hi; };
struct KPtr { const __attribute__((address_space(4))) Params* q; };
typedef const KPtr KP;
#define p (*P_.q)

typedef __bf16 bf16v2 __attribute__((ext_vector_type(2)));
__device__ __forceinline__ unsigned cvt_pk_bf16(float lo, float hi) { const bf16v2 v = __builtin_convertvector((f32x2){lo, hi}, bf16v2); return __builtin_bit_cast(unsigned, v); }
__device__ __forceinline__ bf16_t f2bf(float f) { return (bf16_t)(cvt_pk_bf16(f, 0.f) & 0xffffu); }
__device__ __forceinline__ float bf2f(bf16_t b) { return __uint_as_float(((unsigned)b) << 16); }
__device__ __forceinline__ float bflo(unsigned w) { return __uint_as_float(w << 16); }
__device__ __forceinline__ float bfhi(unsigned w) { return __uint_as_float(w & 0xffff0000u); }
__device__ __forceinline__ void unpack8(const u32x4 v, float* o) { o[0] = bflo(v.x); o[1] = bfhi(v.x); o[2] = bflo(v.y); o[3] = bfhi(v.y); o[4] = bflo(v.z); o[5] = bfhi(v.z); o[6] = bflo(v.w); o[7] = bfhi(v.w); }
__device__ __forceinline__ u32x4 pack8(const float* o) { u32x4 v; v.x = cvt_pk_bf16(o[0], o[1]); v.y = cvt_pk_bf16(o[2], o[3]); v.z = cvt_pk_bf16(o[4], o[5]); v.w = cvt_pk_bf16(o[6], o[7]); return v; }
__device__ __forceinline__ u32x2 pack4(const f32x4 a) { u32x2 v; v.x = cvt_pk_bf16(a[0], a[1]); v.y = cvt_pk_bf16(a[2], a[3]); return v; }
__device__ __forceinline__ float sigmoidf_(float x) { return __builtin_amdgcn_rcpf(1.0f + __expf(-x)); }
__device__ __forceinline__ float siluf_(float x) { return x * __builtin_amdgcn_rcpf(1.0f + __expf(-x)); }
__device__ __forceinline__ float softplusf_(float x) { return x > 20.f ? x : log1pf(expf(x)); }
__device__ __forceinline__ float gelu_tanh(float x) { const float e = __builtin_amdgcn_exp2f(x * (-2.302208198f - 0.102943240f * x * x)); return x * __builtin_amdgcn_rcpf(1.0f + e); }
__device__ __forceinline__ int tidx() { int t = threadIdx.x; asm volatile("" : "+v"(t)); return t; }
#define LBAR() do { asm volatile("s_waitcnt lgkmcnt(0)" ::: "memory"); __builtin_amdgcn_s_barrier(); asm volatile("" ::: "memory"); } while (0)
#define MFMA16(a, b, c) __builtin_amdgcn_mfma_f32_16x16x32_bf16((a), (b), (c), 0, 0, 0)

__device__ void phase_init(KP& P_) {
    const float* x = p.in[0]; const float* meta = p.in[1];
    bf16_t* xb = (bf16_t*)(p.ws + WS_PRE);
    const size_t total = (size_t)MR * 256, GT = (size_t)gridDim.x * NTHR;
    for (size_t i0 = (size_t)blockIdx.x * NTHR + tidx(); i0 < total; i0 += 4 * GT) {
        f32x4 v[4];
#pragma unroll
        for (int q = 0; q < 4; ++q) { const size_t i = i0 + q * GT; v[q] = (f32x4){0.f, 0.f, 0.f, 0.f};
            if (i < total) { const int row = (int)(i >> 8), c4 = (int)(i & 255) * 4; const int b = row / LP, r = row - b * LP;
                if (r >= 64) v[q] = *(const f32x4*)(x + ((size_t)(b * SEQ + r - 64)) * DM + c4);
                else if (r >= PADR) v[q] = *(const f32x4*)(meta + (size_t)(r - PADR) * DM + c4); } }
#pragma unroll
        for (int q = 0; q < 4; ++q) { const size_t i = i0 + q * GT; if (i < total) { const int row = (int)(i >> 8), c4 = (int)(i & 255) * 4; *(u32x2*)(xb + (size_t)row * DM + c4) = pack4(v[q]); } }
    }
}

__device__ void conv_unit(LAS unsigned char* lds, const float* src, int ld, int sn0, int nvalid, int k0, int krows,
                          bf16_t* dst, int dn0, int Kdst, int kd0, const float* gs, const float* bs, float* c1, float* c2) {
    LAS bf16_t* T = (LAS bf16_t*)lds;
    LAS float* red = (LAS float*)(lds + 9216);
    const int tid = tidx(), kl = tid >> 3, ng = (tid & 7) * 8;
    float a1[8], a2[8], wn[8], gn, bn;
#pragma unroll
    for (int j = 0; j < 8; ++j) { a1[j] = 0.f; a2[j] = 0.f; }
    const int nkt = krows / 64;
    { const int k = k0 + kl; gn = gs ? gs[k] : 1.f; bn = bs ? bs[k] : 0.f;
#pragma unroll
      for (int j = 0; j < 8; ++j) wn[j] = (ng + j < nvalid) ? src[(size_t)k * ld + sn0 + ng + j] : 0.f; }
    for (int kt = 0; kt < nkt; ++kt) {
        float w[8]; const float g = gn, b = bn;
#pragma unroll
        for (int j = 0; j < 8; ++j) w[j] = wn[j];
        if (kt + 1 < nkt) { const int k = k0 + (kt + 1) * 64 + kl; gn = gs ? gs[k] : 1.f; bn = bs ? bs[k] : 0.f;
#pragma unroll
            for (int j = 0; j < 8; ++j) wn[j] = (ng + j < nvalid) ? src[(size_t)k * ld + sn0 + ng + j] : 0.f; }
#pragma unroll
        for (int j = 0; j < 8; ++j) { const bf16_t wb = f2bf(w[j] * g); a1[j] += bf2f(wb); a2[j] += b * w[j]; T[(ng + j) * 72 + kl] = wb; }
        LBAR();
        { const int n = tid >> 3, ks = (tid & 7) * 8; const u32x4 v = *(const LAS u32x4*)(T + n * 72 + ks);
          *(u32x4*)(dst + (size_t)(dn0 + n) * Kdst + kd0 + kt * 64 + ks) = v; }
        LBAR();
    }
    if (c1) {
#pragma unroll
        for (int j = 0; j < 8; ++j) red[kl * 65 + ng + j] = a1[j];
        LBAR();
        if (tid < 64) { float sm = 0.f; for (int q = 0; q < 64; ++q) sm += red[q * 65 + tid]; c1[dn0 + tid] = sm; }
        LBAR();
#pragma unroll
        for (int j = 0; j < 8; ++j) red[kl * 65 + ng + j] = a2[j];
        LBAR();
        if (tid < 64) { float sm = 0.f; for (int q = 0; q < 64; ++q) sm += red[q * 65 + tid]; c2[dn0 + tid] = sm; }
        LBAR();
    }
}

__device__ void weights_units(LAS unsigned char* lds, KP& P0, int lm0, int li0, int ufirst, int ustride) {
    const int n_m = lm0 >= 0 ? 144 : 0, n_i = li0 >= 0 ? 49 : 0, NU = n_m + n_i;
    for (int u = ufirst; u < NU; u += ustride) {
        KPtr P_ = P0; int lm = __builtin_amdgcn_readfirstlane(lm0), li = __builtin_amdgcn_readfirstlane(li0); asm volatile("" : "+s"(P_.q), "+s"(lm), "+s"(li));
        unsigned char* ob = (unsigned char*)p.out; unsigned char* ws = p.ws;
        if (u < n_m) {
            if (u < 64) { const float* w1 = p.in[24] + (size_t)lm * DM * DFF;
                conv_unit(lds, w1, DFF, u * 64, 64, 0, 1024, (bf16_t*)(ob + OUT_W1), u * 64, 1024, 0, p.in[22] + (size_t)lm * DM, p.in[23] + (size_t)lm * DM, (float*)(ws + WS_C1MLP), (float*)(ws + WS_C2MLP)); }
            else if (u < 128) { const int j = (u - 64) & 15, kq = (u - 64) >> 4; const float* w2 = p.in[25] + (size_t)lm * DFF * DM;
                conv_unit(lds, w2, DM, j * 64, 64, kq * 1024, 1024, (bf16_t*)(ob + OUT_W2), j * 64, DFF, kq * 1024, nullptr, nullptr, nullptr, nullptr); }
            else { const int j = u - 128; const float* w_out = p.in[21] + (size_t)lm * DM * DM;
                conv_unit(lds, w_out, DM, j * 64, 64, 0, 1024, (bf16_t*)(ob + OUT_WOUT), j * 64, 1024, 0, nullptr, nullptr, nullptr, nullptr); }
        } else {
            const int j = u - n_m; int sn0, nvalid = 64;
            if (j < 44) sn0 = j * 64; else if (j < 48) sn0 = 2822 + (j - 44) * 64; else { sn0 = 2816; nvalid = 6; }
            const float* w_in = p.in[2] + (size_t)li * DM * DIN;
            const float* g_in = li > 0 ? p.in[26] + (size_t)(li - 1) * DM : nullptr; const float* b_in = li > 0 ? p.in[27] + (size_t)(li - 1) * DM : nullptr;
            conv_unit(lds, w_in, DIN, sn0, nvalid, 0, 1024, (bf16_t*)(ob + OUT_WIN), j * 64, 1024, 0, g_in, b_in, (float*)(ws + WS_C1IN), (float*)(ws + WS_C2IN));
        }
    }
}
__device__ void tables_units(LAS unsigned char* lds, KP& P0, int l0, int wg0) {
    const int G = gridDim.x;
    for (int u = ((int)blockIdx.x - wg0 + G) % G; u < 7; u += G) {
        KPtr P_ = P0; int l = l0; asm volatile("" : "+s"(P_.q), "+s"(l));
        unsigned char* ws = p.ws;
        if (u < 4) conv_unit(lds, p.in[19] + (size_t)l * 65536, 256, u * 64, 64, 0, 256, (bf16_t*)(ws + TBL(T_GLUT, l)), u * 64, 256, 0, nullptr, nullptr, nullptr, nullptr);
        else if (u < 6) {
            const int id = (u - 4) * 512 + tidx(), g = id >> 6, n = id & 63; const int gi = (l * 16 + g) * 64 + n;
            const float lre = fminf(p.in[11][gi], -1e-4f), lim = p.in[12][gi], dt = expf(p.in[13][l * 16 + g]);
            const float mag = expf(lre * dt); const float lbr = mag * cosf(lim * dt), lbi = mag * sinf(lim * dt);
            const float den = lre * lre + lim * lim, nr = lbr - 1.0f;
            const float sre = (nr * lre + lbi * lim) / den, sim = (lbi * lre - nr * lim) / den;
            float pr = lbr, pi = lbi;
            for (int q = 0; q < 6; ++q) { const float t = pr * pr - pi * pi; pi = 2.f * pr * pi; pr = t; }
            float* lam = (float*)(ws + TBL(T_S5LAM, l)) + (size_t)(g * 64 + n) * 4; lam[0] = lbr; lam[1] = lbi; lam[2] = pr; lam[3] = pi;
            float bb[32];
            bf16_t* bbh = (bf16_t*)(ws + TBL(T_S5BBH, l)) + (size_t)(g * 128 + 2 * n) * 16;
            for (int c = 0; c < 16; ++c) { const float br = p.in[14][(size_t)gi * 16 + c], bi = p.in[15][(size_t)gi * 16 + c]; bb[c] = sre * br - sim * bi; bb[16 + c] = sre * bi + sim * br; bbh[c] = f2bf(bb[c]); bbh[16 + c] = f2bf(bb[16 + c]); }
            bf16_t* cm = (bf16_t*)(ws + TBL(T_S5C, l));
            for (int c = 0; c < 16; ++c) { const size_t ci = ((size_t)(l * 16 + g) * 16 + c) * 64 + n; cm[(size_t)(g * 16 + c) * 128 + 2 * n] = f2bf(p.in[16][ci]); cm[(size_t)(g * 16 + c) * 128 + 2 * n + 1] = f2bf(-p.in[17][ci]); }
        } else {
            if (tidx() < 384) { const int c = tidx(); float v[4], mx = -1e30f; for (int q = 0; q < 4; ++q) { v[q] = p.in[3][q * 384 + c]; mx = fmaxf(mx, v[q]); }
                float sm = 0.f; for (int q = 0; q < 4; ++q) { v[q] = expf(v[q] - mx); sm += v[q]; } float a = 0.f; for (int q = 1; q <= l; ++q) a += v[q] / sm;
                ((float*)(ws + TBL(T_LB, l)))[c] = a; }
        }
    }
}

constexpr int HTB = 16384;
__device__ __forceinline__ int lds_byte(int r, int c) { const int st = (r >> 4) * 2 + (c >> 5), rr = r & 15, cc = c & 31, ob = rr * 64 + cc * 2; return st * 1024 + (ob ^ (((ob >> 9) & 1) << 5)); }
__device__ __forceinline__ void stage_rc(int b, int& R, int& C) { const int st = b / 1024, sb = b % 1024, swz = sb ^ (((sb >> 9) & 1) << 5); R = (st >> 1) * 16 + swz / 64; C = (st & 1) * 32 + (swz % 64) / 2; }

struct RowInfo { float mu, rstd; int pad; };

__device__ __forceinline__ int prow0(int pm) { return (pm >> 4) * LP + PADR + (pm & 15) * 256; }
__device__ __forceinline__ int trow(int i) { return (i >> 4) * LP + 4144 + (i & 15); }
__device__ __forceinline__ void prep_rowstats(const float* stat, int pm, int par, LAS unsigned char* lds) {
    const int t = tidx();
    if (t < (pm < 64 ? 256 : 64)) {
        const int row = pm < 64 ? prow0(pm) + t : trow(t); const f32x4* sp = (const f32x4*)(stat + (size_t)row * 32);
        float s1 = 0.f, s2 = 0.f;
#pragma unroll
        for (int q = 0; q < 8; ++q) { const f32x4 v = sp[q]; s1 += v[0] + v[2]; s2 += v[1] + v[3]; }
        const float mu = s1 * (1.0f / 1024.0f); const float var = fmaxf(s2 * (1.0f / 1024.0f) - mu * mu, 0.f);
        ((LAS f32x2*)(lds + RS_OFF + par * 2048))[t] = (f32x2){mu, __builtin_amdgcn_rsqf(var + LN_EPS)};
    }
}

struct ColInfo { f32x4 a, b; };
struct EpiInProj {
    static constexpr bool STATS = false, PRELOAD = false;
    const float* stat; const float* c1; const float* c2; bf16_t* proj; float* dtbuf; const float* dtbias; float* stat_out; int fold;
    __device__ __forceinline__ void prep(int pm, int par, LAS unsigned char* lds) const { if (fold) prep_rowstats(stat, pm, par, lds); }
    __device__ __forceinline__ RowInfo rowinfo(int row, int lrow, int par, LAS unsigned char* lds) const {
        RowInfo r; r.mu = 0.f; r.rstd = 1.f; if (fold) { const f32x2 sv = ((const LAS f32x2*)(lds + RS_OFF + par * 2048))[lrow]; r.mu = sv.x; r.rstd = sv.y; }
        r.pad = 0; return r; }
    __device__ __forceinline__ ColInfo colinfo(int col) const { ColInfo c; c.a = (f32x4){0.f, 0.f, 0.f, 0.f}; c.b = c.a; if (fold) { c.a = *(const f32x4*)(c1 + col); c.b = *(const f32x4*)(c2 + col); } return c; }
    __device__ __forceinline__ f32x4 preload(int row, int col) const { return (f32x4){0.f, 0.f, 0.f, 0.f}; }
    __device__ __forceinline__ u32x2 preload_pk(int row, int col) const { return (u32x2){0u, 0u}; }
    __device__ __forceinline__ void apply(const RowInfo& ri, const ColInfo& ci, int row, int col, f32x4 a, f32x4 pv, float& s1, float& s2) const {
        f32x4 v = a;
        if (fold) v = (a - ci.a * ri.mu) * ri.rstd + ci.b;
        if (ri.pad) v = (f32x4){0.f, 0.f, 0.f, 0.f};
        *(u32x2*)(proj + (size_t)row * NPROJ + col) = pack4(v);
    }
};
struct EpiResid {
    static constexpr bool STATS = true, PRELOAD = true;
    const float* stat; const float* g; const float* b; bf16_t* xb; float* stat_out; int ident;
    __device__ __forceinline__ void prep(int pm, int par, LAS unsigned char* lds) const { if (!ident) prep_rowstats(stat, pm, par, lds); }
    __device__ __forceinline__ RowInfo rowinfo(int row, int lrow, int par, LAS unsigned char* lds) const {
        RowInfo r; r.mu = 0.f; r.rstd = 1.f; r.pad = 0; if (!ident) { const f32x2 sv = ((const LAS f32x2*)(lds + RS_OFF + par * 2048))[lrow]; r.mu = sv.x; r.rstd = sv.y; } return r; }
    __device__ __forceinline__ ColInfo colinfo(int col) const { ColInfo c; c.a = (f32x4){0.f, 0.f, 0.f, 0.f}; c.b = c.a; return c; }
    __device__ __forceinline__ f32x4 preload(int row, int col) const { const u32x2 w = *(const u32x2*)(xb + (size_t)row * DM + col); return (f32x4){bflo(w.x), bfhi(w.x), bflo(w.y), bfhi(w.y)}; }
    __device__ __forceinline__ u32x2 preload_pk(int row, int col) const { return *(const u32x2*)(xb + (size_t)row * DM + col); }
    __device__ __forceinline__ void apply(const RowInfo& ri, const ColInfo& ci, int row, int col, f32x4 a, f32x4 pv, float& s1, float& s2) const {
        f32x4 h = pv;
        if (!ident) { const f32x4 gg = *(const f32x4*)(g + col), bb = *(const f32x4*)(b + col); h = (pv - ri.mu) * ri.rstd * gg + bb; }
        const f32x4 v = h * ALPHA + a;
        *(u32x2*)(xb + (size_t)row * DM + col) = pack4(v);
        s1 += (v[0] + v[1]) + (v[2] + v[3]); s2 += (v[0] * v[0] + v[1] * v[1]) + (v[2] * v[2] + v[3] * v[3]);
    }
};
struct EpiMlpIn {
    static constexpr bool STATS = false, PRELOAD = false;
    const float* stat; const float* c1; const float* c2; bf16_t* hid; float* stat_out;
    __device__ __forceinline__ void prep(int pm, int par, LAS unsigned char* lds) const { prep_rowstats(stat, pm, par, lds); }
    __device__ __forceinline__ RowInfo rowinfo(int row, int lrow, int par, LAS unsigned char* lds) const {
        RowInfo r; const f32x2 sv = ((const LAS f32x2*)(lds + RS_OFF + par * 2048))[lrow]; r.mu = sv.x; r.rstd = sv.y; r.pad = 0; return r; }
    __device__ __forceinline__ ColInfo colinfo(int col) const { ColInfo c; c.a = *(const f32x4*)(c1 + col); c.b = *(const f32x4*)(c2 + col); return c; }
    __device__ __forceinline__ f32x4 preload(int row, int col) const { return (f32x4){0.f, 0.f, 0.f, 0.f}; }
    __device__ __forceinline__ u32x2 preload_pk(int row, int col) const { return (u32x2){0u, 0u}; }
    __device__ __forceinline__ void apply(const RowInfo& ri, const ColInfo& ci, int row, int col, f32x4 a, f32x4 pv, float& s1, float& s2) const {
        f32x4 v = (a - ci.a * ri.mu) * ri.rstd + ci.b;
#pragma unroll
        for (int j = 0; j < 4; ++j) { const float r = fmaxf(v[j], 0.f); v[j] = r * r; }
        *(u32x2*)(hid + (size_t)row * DFF + col) = pack4(v);
    }
};

template <class Epi>
__device__ __forceinline__ void gemm_phase(LAS unsigned char* lds, const bf16_t* Ag, const bf16_t* Btg, const int K, const int nM, const int nN, const Epi& E) {
    const int tid = tidx(), wid = __builtin_amdgcn_readfirstlane(tid >> 6), lane = tid & 63, wr = wid >> 2, wc = wid & 3, fr = lane & 15, fq = lane >> 4;
    const int nt = K / 64, G = gridDim.x, nunits = nM * nN;
    int u = blockIdx.x; if (u >= nunits) return;
    unsigned voff[2];
#pragma unroll
    for (int i = 0; i < 2; ++i) { int R, C; stage_rc(tid * 16 + i * 8192, R, C); voff[i] = (unsigned)(R * K + C) * 2u; }
    const size_t kstep = 128, hstep = (size_t)128 * K * 2, tstep = 2 * hstep;
    const unsigned ldsw = (unsigned)wid * 1024u;
    const int aoff = lds_byte(wr * 64 + fr, fq * 8), boff = lds_byte(wc * 32 + fr, fq * 8);
#define G_SA(b, h) (((b) * 2 + (h)) * HTB)
#define G_SB(b, h) ((4 + (b) * 2 + (h)) * HTB)
#define G_STAGE(bufoff, gbase) do { _Pragma("unroll") for (int _i = 0; _i < 2; ++_i) \
        __builtin_amdgcn_global_load_lds((const unsigned*)((const char*)(gbase) + voff[_i]), (LAS unsigned*)(lds + (bufoff) + ldsw + _i * 8192), 16, 0, 0); } while (0)
#define G_LDA(dst, b, h) do { _Pragma("unroll") for (int m = 0; m < 4; ++m) _Pragma("unroll") for (int k = 0; k < 2; ++k) dst[m][k] = *(const LAS bf16x8*)(lds + G_SA(b, h) + aoff + m * 2048 + k * 1024); } while (0)
#define G_LDB(dst, b, h) do { _Pragma("unroll") for (int n = 0; n < 2; ++n) _Pragma("unroll") for (int k = 0; k < 2; ++k) dst[n][k] = *(const LAS bf16x8*)(lds + G_SB(b, h) + boff + n * 2048 + k * 1024); } while (0)
#define G_MMA(ai, bj, At, Bt) do { __builtin_amdgcn_s_setprio(1); _Pragma("unroll") for (int m = 0; m < 4; ++m) _Pragma("unroll") for (int n = 0; n < 2; ++n) _Pragma("unroll") for (int k = 0; k < 2; ++k) \
        acc[ai][bj][m][n] = MFMA16(Bt[n][k], At[m][k], acc[ai][bj][m][n]); __builtin_amdgcn_s_setprio(0); } while (0)
#define G_WAIT_V(n) asm volatile("s_waitcnt vmcnt(" #n ")" ::: "memory")
#define G_WAIT_L(n) asm volatile("s_waitcnt lgkmcnt(" #n ")" ::: "memory")
#define G_BAR __builtin_amdgcn_s_barrier()
#define G_SCHED __builtin_amdgcn_sched_barrier(0)
    int pm = u % nM, pn = u / nM, par = 0;
    f32x4 acc[2][2][4][2];
#pragma unroll
    for (int a = 0; a < 2; ++a)
#pragma unroll
        for (int b = 0; b < 2; ++b)
#pragma unroll
            for (int m = 0; m < 4; ++m)
#pragma unroll
                for (int n = 0; n < 2; ++n) acc[a][b][m][n] = (f32x4){0.f, 0.f, 0.f, 0.f};
    bf16x8 At[4][2], B0[2][2], B1[2][2];
    const size_t rstep = (size_t)K * 2;
    const char* cA = (const char*)Ag + (size_t)prow0(pm) * rstep; const char* cB = (const char*)Btg + (size_t)pn * tstep;
    E.prep(pm, par, lds);
    G_STAGE(G_SB(0, 0), cB); G_STAGE(G_SA(0, 0), cA); G_STAGE(G_SB(0, 1), cB + hstep); G_STAGE(G_SA(0, 1), cA + hstep);
    if (wr == 1) G_BAR;
    G_WAIT_V(4); G_BAR;
    G_STAGE(G_SB(1, 0), cB + kstep); G_STAGE(G_SA(1, 0), cA + kstep); G_STAGE(G_SB(1, 1), cB + hstep + kstep);
    G_WAIT_V(6); G_BAR;
    for (;;) {
        const int un = u + G; const bool has_next = un < nunits; const int pmn = has_next ? un % nM : pm, pnn = has_next ? un / nM : pn;
        const char* nA = has_next ? (const char*)Ag + (size_t)prow0(pmn) * rstep : cA; const char* nB = has_next ? (const char*)Btg + (size_t)pnn * tstep : cB;
        for (int t = 0; t < nt; t += 2) {
            const bool last = (t == nt - 2);
            const char* a1 = cA + (size_t)(t + 1) * kstep;
            const char* a2 = last ? nA : cA + (size_t)(t + 2) * kstep; const char* b2 = last ? nB : cB + (size_t)(t + 2) * kstep;
            const char* a3 = a2 + kstep; const char* b3 = b2 + kstep;
            if (last && has_next && pmn != pm) E.prep(pmn, par ^ 1, lds);
            G_LDB(B0, 0, 0); G_SCHED; G_LDA(At, 0, 0); G_STAGE(G_SA(1, 1), a1 + hstep);
            G_WAIT_L(8); G_BAR; G_WAIT_L(0); G_MMA(0, 0, At, B0); G_BAR; G_SCHED;
            G_LDB(B1, 0, 1); G_STAGE(G_SB(0, 0), b2);
            G_BAR; G_WAIT_L(0); G_MMA(0, 1, At, B1); G_BAR;
            G_LDA(At, 0, 1); G_STAGE(G_SA(0, 0), a2);
            G_BAR; G_WAIT_L(0); G_MMA(1, 0, At, B0); G_BAR; G_SCHED;
            G_STAGE(G_SB(0, 1), b2 + hstep);
            G_WAIT_V(6); G_BAR; G_MMA(1, 1, At, B1); G_BAR;
            G_LDB(B0, 1, 0); G_SCHED; G_LDA(At, 1, 0); G_STAGE(G_SA(0, 1), a2 + hstep);
            G_WAIT_L(8); G_BAR; G_WAIT_L(0); G_MMA(0, 0, At, B0); G_BAR; G_SCHED;
            G_LDB(B1, 1, 1); G_STAGE(G_SB(1, 0), b3);
            G_BAR; G_WAIT_L(0); G_MMA(0, 1, At, B1); G_BAR;
            G_LDA(At, 1, 1); G_STAGE(G_SA(1, 0), a3);
            G_BAR; G_WAIT_L(0); G_MMA(1, 0, At, B0); G_BAR; G_SCHED;
            G_STAGE(G_SB(1, 1), b3 + hstep);
            G_WAIT_V(6); G_BAR; G_MMA(1, 1, At, B1); G_BAR;
        }
        {
            ColInfo ci[2][2];
#pragma unroll
            for (int bj = 0; bj < 2; ++bj)
#pragma unroll
                for (int n = 0; n < 2; ++n) ci[bj][n] = E.colinfo(pn * 256 + bj * 128 + wc * 32 + n * 16 + fq * 4);
            u32x2 pk[4][2][2];
#pragma unroll
            for (int gi = 0; gi < 8; ++gi) {
                const int ai = gi >> 2, m = gi & 3;
                const int lrow = ai * 128 + wr * 64 + m * 16 + fr, row = prow0(pm) + lrow;
                if (!Epi::PRELOAD && gi == 0) {
#pragma unroll
                    for (int g2 = 0; g2 < 4; ++g2)
#pragma unroll
                        for (int bj = 0; bj < 2; ++bj)
#pragma unroll
                            for (int n = 0; n < 2; ++n) pk[g2][bj][n] = (u32x2){0u, 0u};
                }
                if (Epi::PRELOAD && m == 0) {
#pragma unroll
                    for (int g2 = 0; g2 < 4; ++g2)
#pragma unroll
                        for (int bj = 0; bj < 2; ++bj)
#pragma unroll
                            for (int n = 0; n < 2; ++n) pk[g2][bj][n] = E.preload_pk(prow0(pm) + ai * 128 + wr * 64 + g2 * 16 + fr, pn * 256 + bj * 128 + wc * 32 + n * 16 + fq * 4);
                }
                f32x4 pv[2][2];
#pragma unroll
                for (int bj = 0; bj < 2; ++bj)
#pragma unroll
                    for (int n = 0; n < 2; ++n) { const u32x2 w = pk[m][bj][n]; pv[bj][n] = (f32x4){bflo(w.x), bfhi(w.x), bflo(w.y), bfhi(w.y)}; }
                const RowInfo ri = E.rowinfo(row, lrow, par, lds);
                float s1 = 0.f, s2 = 0.f;
#pragma unroll
                for (int bj = 0; bj < 2; ++bj)
#pragma unroll
                    for (int n = 0; n < 2; ++n) E.apply(ri, ci[bj][n], row, pn * 256 + bj * 128 + wc * 32 + n * 16 + fq * 4, acc[ai][bj][m][n], pv[bj][n], s1, s2);
                if (Epi::STATS) {
                    s1 += __shfl_xor(s1, 16); s1 += __shfl_xor(s1, 32); s2 += __shfl_xor(s2, 16); s2 += __shfl_xor(s2, 32);
                    if (fq == 0) *(f32x2*)(E.stat_out + ((size_t)row * 16 + pn * 4 + wc) * 2) = (f32x2){s1, s2};
                }
                asm volatile("" ::: "memory");
            }
        }
        if (!has_next) break;
#pragma unroll
        for (int a = 0; a < 2; ++a)
#pragma unroll
            for (int b = 0; b < 2; ++b)
#pragma unroll
                for (int m = 0; m < 4; ++m)
#pragma unroll
                    for (int n = 0; n < 2; ++n) acc[a][b][m][n] = (f32x4){0.f, 0.f, 0.f, 0.f};
        if (pmn != pm) par ^= 1;
        u = un; pm = pmn; pn = pnn; cA = nA; cB = nB;
    }
    G_WAIT_V(0);
    if (wr == 0) G_BAR;
    G_BAR;
}


template <class Epi>
__device__ __forceinline__ void gemm_tail(LAS unsigned char* lds, const bf16_t* Ag, const bf16_t* Btg, const int K, const int N, const Epi& E, const int ufirst, const int ustride) {
    const int tid = tidx(), wid = tid >> 6, lane = tid & 63, fr = lane & 15, fq = lane >> 4;
    LAS float* red = (LAS float*)lds;
    const int nunits = 4 * (N / 64), ks = K / 8, nch = ks / 128, G = ustride;
    int u = ufirst;
    bf16x8 af[4], bf[4][4];
#define T_LOAD(uu, cc) do { const int _rb = (uu) & 3, _cb = (uu) >> 2; \
        const bf16_t* _ap = Ag + (size_t)trow(_rb * 16 + fr) * K + wid * ks + (cc) * 128 + fq * 8; \
        const bf16_t* _bp = Btg + (size_t)(_cb * 64 + fr) * K + wid * ks + (cc) * 128 + fq * 8; \
        _Pragma("unroll") for (int s_ = 0; s_ < 4; ++s_) { af[s_] = *(const bf16x8*)(_ap + s_ * 32); \
            _Pragma("unroll") for (int n_ = 0; n_ < 4; ++n_) bf[s_][n_] = *(const bf16x8*)(_bp + (size_t)n_ * 16 * K + s_ * 32); } } while (0)
    if (u < nunits) T_LOAD(u, 0);
    E.prep(64, 0, lds);
    LBAR();
    if (u >= nunits) return;
    int c = 0;
    f32x4 acc[4];
#pragma unroll
    for (int n = 0; n < 4; ++n) acc[n] = (f32x4){0.f, 0.f, 0.f, 0.f};
    for (;;) {
        bf16x8 caf[4], cbf[4][4];
#pragma unroll
        for (int s_ = 0; s_ < 4; ++s_) { caf[s_] = af[s_];
#pragma unroll
            for (int n_ = 0; n_ < 4; ++n_) cbf[s_][n_] = bf[s_][n_]; }
        const bool lastc = (c + 1 == nch); const int un = lastc ? u + G : u, cn = lastc ? 0 : c + 1; const bool more = un < nunits;
        ColInfo cie; cie.a = (f32x4){0.f, 0.f, 0.f, 0.f}; cie.b = cie.a; f32x4 pve = (f32x4){0.f, 0.f, 0.f, 0.f};
        if (lastc && tid < 256) { const int ecol = (u >> 2) * 64 + (tid & 15) * 4; cie = E.colinfo(ecol); pve = E.preload(trow((u & 3) * 16 + (tid >> 4)), ecol); }
        if (more) T_LOAD(un, cn);
#pragma unroll
        for (int s_ = 0; s_ < 4; ++s_)
#pragma unroll
            for (int n_ = 0; n_ < 4; ++n_) acc[n_] = MFMA16(cbf[s_][n_], caf[s_], acc[n_]);
        if (lastc) {
            const int rb = u & 3, cb = u >> 2;
#pragma unroll
            for (int n = 0; n < 4; ++n) { *(LAS f32x4*)(red + (wid * 16 + fr) * 68 + n * 16 + fq * 4) = acc[n]; acc[n] = (f32x4){0.f, 0.f, 0.f, 0.f}; }
            LBAR();
            if (tid < 256) {
                const int r = tid >> 4, c4 = (tid & 15) * 4; f32x4 v = (f32x4){0.f, 0.f, 0.f, 0.f};
#pragma unroll
                for (int w = 0; w < 8; ++w) v += *(const LAS f32x4*)(red + (w * 16 + r) * 68 + c4);
                const int lrow = rb * 16 + r, row = trow(lrow); const RowInfo ri = E.rowinfo(row, lrow, 0, lds);
                float s1 = 0.f, s2 = 0.f; E.apply(ri, cie, row, cb * 64 + c4, v, pve, s1, s2);
                if (Epi::STATS) {
#pragma unroll
                    for (int o = 1; o < 16; o <<= 1) { s1 += __shfl_xor(s1, o); s2 += __shfl_xor(s2, o); }
                    if ((tid & 15) == 0) *(f32x2*)(E.stat_out + ((size_t)row * 16 + cb) * 2) = (f32x2){s1, s2};
                }
            }
            LBAR();
        }
        if (!more) break;
        u = un; c = cn;
    }
#undef T_LOAD
}
template <class Epi>
__device__ __forceinline__ void gemm_tail16(LAS unsigned char* lds, const bf16_t* Ag, const bf16_t* Btg, const int K, const Epi& E) {
    const int tid = tidx(), wid = tid >> 6, lane = tid & 63, fr = lane & 15, fq = lane >> 4;
    LAS float* red = (LAS float*)lds;
    const int ks = K / 8, nch = ks / 128;
    bool first = true;
    for (int u = blockIdx.x; u < 256; u += gridDim.x) {
        const int rb = u & 3, cb = u >> 2;
        ColInfo cie; cie.a = (f32x4){0.f, 0.f, 0.f, 0.f}; cie.b = cie.a; f32x4 pve = (f32x4){0.f, 0.f, 0.f, 0.f};
        if (tid < 64) { const int ecol = cb * 16 + (tid & 3) * 4; cie = E.colinfo(ecol); pve = E.preload(trow(rb * 16 + (tid >> 2)), ecol); }
        const bf16_t* ap = Ag + (size_t)trow(rb * 16 + fr) * K + wid * ks + fq * 8;
        const bf16_t* bp = Btg + (size_t)(cb * 16 + fr) * K + wid * ks + fq * 8;
        bf16x8 af[4], bf[4];
#pragma unroll
        for (int s_ = 0; s_ < 4; ++s_) { af[s_] = *(const bf16x8*)(ap + s_ * 32); bf[s_] = *(const bf16x8*)(bp + s_ * 32); }
        if (first) { E.prep(64, 0, lds); first = false; }
        f32x4 acc = (f32x4){0.f, 0.f, 0.f, 0.f};
        for (int c = 0; c < nch; ++c) {
            bf16x8 ca[4], cbf[4];
#pragma unroll
            for (int s_ = 0; s_ < 4; ++s_) { ca[s_] = af[s_]; cbf[s_] = bf[s_]; }
            if (c + 1 < nch) {
#pragma unroll
                for (int s_ = 0; s_ < 4; ++s_) { af[s_] = *(const bf16x8*)(ap + (c + 1) * 128 + s_ * 32); bf[s_] = *(const bf16x8*)(bp + (c + 1) * 128 + s_ * 32); } }
#pragma unroll
            for (int s_ = 0; s_ < 4; ++s_) acc = MFMA16(cbf[s_], ca[s_], acc);
        }
        *(LAS f32x4*)(red + (wid * 16 + fr) * 20 + fq * 4) = acc;
        LBAR();
        if (tid < 64) {
            const int r = tid >> 2, c4 = (tid & 3) * 4; f32x4 v = (f32x4){0.f, 0.f, 0.f, 0.f};
#pragma unroll
            for (int w = 0; w < 8; ++w) v += *(const LAS f32x4*)(red + (w * 16 + r) * 20 + c4);
            const int lrow = rb * 16 + r, row = trow(lrow); const RowInfo ri = E.rowinfo(row, lrow, 0, lds);
            float s1 = 0.f, s2 = 0.f; E.apply(ri, cie, row, cb * 16 + c4, v, pve, s1, s2);
            s1 += __shfl_xor(s1, 1); s1 += __shfl_xor(s1, 2); s2 += __shfl_xor(s2, 1); s2 += __shfl_xor(s2, 2);
            if ((tid & 3) == 0) { float* sp = E.stat_out + ((size_t)row * 16 + (cb >> 2)) * 2; atomicAdd(sp, s1); atomicAdd(sp + 1, s2); }
        }
        LBAR();
    }
}
__device__ __forceinline__ void zero_tail_stats(float* stat) {
    if (blockIdx.x == 0) for (int i = tidx(); i < 64 * 32; i += NTHR) stat[(size_t)trow(i >> 5) * 32 + (i & 31)] = 0.f;
}
__device__ __forceinline__ void dt_units(LAS unsigned char* lds, const bf16_t* xb, const bf16_t* WinT, const float* stat, const float* c1, const float* c2, float* dtbuf, int fold, bf16_t* proj, const int ufirst, const int ustride, const int uend) {
    const int tid = tidx(), wid = tid >> 6, lane = tid & 63, fr = lane & 15, fq = lane >> 4, rb4 = wid & 3, kh = wid >> 2;
    LAS float* red = (LAS float*)lds;
    for (int u = ufirst; u < uend; u += ustride) {
        if (u % NCHB == 0) {
            for (int i = tid; i < PADR * (NPROJ / 8); i += NTHR) { const int r = i / (NPROJ / 8), c8 = (i - r * (NPROJ / 8)) * 8; *(u32x4*)(proj + ((size_t)u * 64 + r) * NPROJ + c8) = (u32x4){0u, 0u, 0u, 0u}; }
        }
        const bf16_t* ap = xb + (size_t)(u * 64 + rb4 * 16 + fr) * 1024 + kh * 512 + fq * 8;
        const bf16_t* bp = WinT + (size_t)(NPROJ + fr) * 1024 + kh * 512 + fq * 8;
        f32x4 acc = (f32x4){0.f, 0.f, 0.f, 0.f};
        { bf16x8 af[16], bf[16];
#pragma unroll
            for (int s = 0; s < 16; ++s) { af[s] = *(const bf16x8*)(ap + s * 32); bf[s] = *(const bf16x8*)(bp + s * 32); }
#pragma unroll
            for (int s = 0; s < 16; ++s) acc = MFMA16(bf[s], af[s], acc);
        }
        *(LAS f32x4*)(red + (kh * 64 + rb4 * 16 + fr) * 20 + fq * 4) = acc;
        LBAR();
        if (tid < 128) {
            const int r = tid >> 1, c4 = (tid & 1) * 4; const int row = u * 64 + r;
            f32x4 v = *(const LAS f32x4*)(red + r * 20 + c4) + *(const LAS f32x4*)(red + (64 + r) * 20 + c4);
            if (fold) {
                const f32x4* sp = (const f32x4*)(stat + (size_t)row * 32); float s1 = 0.f, s2 = 0.f;
#pragma unroll
                for (int q = 0; q < 8; ++q) { const f32x4 t = sp[q]; s1 += t[0] + t[2]; s2 += t[1] + t[3]; }
                const float mu = s1 * (1.0f / 1024.0f), var = fmaxf(s2 * (1.0f / 1024.0f) - mu * mu, 0.f), rstd = __builtin_amdgcn_rsqf(var + LN_EPS);
                const f32x4 k1 = *(const f32x4*)(c1 + NPROJ + c4), k2 = *(const f32x4*)(c2 + NPROJ + c4); v = (v - k1 * mu) * rstd + k2;
            }
            if ((row % LP) < PADR) v = (f32x4){-1e30f, -1e30f, -1e30f, -1e30f};
            if (c4 == 0) *(f32x4*)(dtbuf + (size_t)row * 8) = v; else *(f32x2*)(dtbuf + (size_t)row * 8 + 4) = (f32x2){v[0], v[1]};
        }
        LBAR();
    }
}

typedef unsigned short u16x4_t __attribute__((ext_vector_type(4)));
__device__ __forceinline__ bf16x8 tr_frag(unsigned a0, unsigned a1) {
    u16x4_t x, y;
    asm volatile("ds_read_b64_tr_b16 %0, %2\n\tds_read_b64_tr_b16 %1, %3\n\ts_waitcnt lgkmcnt(0)" : "=&v"(x), "=&v"(y) : "v"(a0), "v"(a1) : "memory");
    bf16x8 r; r[0] = (short)x[0]; r[1] = (short)x[1]; r[2] = (short)x[2]; r[3] = (short)x[3]; r[4] = (short)y[0]; r[5] = (short)y[1]; r[6] = (short)y[2]; r[7] = (short)y[3];
    return r;
}
__device__ __forceinline__ void hgrn_gates(const float* z, const float* lb, float* lf, float* kk) {
#pragma unroll
    for (int j = 0; j < 8; ++j) { const float sp = __builtin_amdgcn_rcpf(1.0f + __expf(-z[j])), sn = 1.0f - sp; const float f = lb[j] + (1.0f - lb[j]) * sp; lf[j] = __builtin_amdgcn_logf(f); kk[j] = (1.0f - lb[j]) * sn; }
}
__device__ __forceinline__ void cumsum64(LAS float* Gf, LAS float* seg) {
    const int tid = tidx(), k = tid & 63, sg = tid >> 6;
    float run = 0.f;
#pragma unroll
    for (int r = 0; r < 8; ++r) { run += Gf[(sg * 8 + r) * 65 + k]; Gf[(sg * 8 + r) * 65 + k] = run; }
    seg[sg * 64 + k] = run;
    LBAR();
    float pre = 0.f;
    for (int s = 0; s < sg; ++s) pre += seg[s * 64 + k];
#pragma unroll
    for (int r = 0; r < 8; ++r) Gf[(sg * 8 + r) * 65 + k] += pre;
    LBAR();
}

struct HgRaw { u32x4 q, f, i; f32x4 lb0, lb1; };
template <int WHICH>
__device__ __forceinline__ HgRaw hg_load(KP& P_, int l, int u, int tid) {
    const bf16_t* proj = (const bf16_t*)(p.ws + WS_PROJ);
    const int idx = u - 780, bc = idx / 6, h = idx - bc * 6, t = tid >> 3, k0 = (tid & 7) * 8; const size_t row = (size_t)bc * 64 + t;
    HgRaw r; r.q = (u32x4){0u, 0u, 0u, 0u};
    if (WHICH) r.q = *(const u32x4*)(proj + row * NPROJ + h * 64 + k0);
    r.f = *(const u32x4*)(proj + row * NPROJ + C_F + h * 64 + k0);
    r.i = *(const u32x4*)(proj + row * NPROJ + C_I + h * 64 + k0);
    const float* lbv = (const float*)(p.ws + TBL(T_LB, l)) + h * 64 + k0; r.lb0 = *(const f32x4*)lbv; r.lb1 = *(const f32x4*)(lbv + 4);
    return r;
}
__device__ __forceinline__ void hgrn_a_unit(LAS unsigned char* lds, KP& P_, int l, int bc, int h, const HgRaw& in) {
    LAS float* Gf = (LAS float*)lds; LAS float* seg = (LAS float*)(lds + 16640);
    LAS bf16_t* KT = (LAS bf16_t*)(lds + 18688); LAS bf16_t* VT = (LAS bf16_t*)(lds + 27904);
    const bf16_t* proj = (const bf16_t*)(p.ws + WS_PROJ); const float* lbv = (const float*)(p.ws + TBL(T_LB, l));
    const int tid = tidx(), t = tid >> 3, k0 = (tid & 7) * 8; const size_t row = (size_t)bc * 64 + t;
    float z[8], iv[8], lf[8], kk[8], lb[8];
    unpack8(in.f, z);
    const u32x4 iraw = in.i;
#pragma unroll
    for (int j = 0; j < 4; ++j) { lb[j] = in.lb0[j]; lb[4 + j] = in.lb1[j]; }
    hgrn_gates(z, lb, lf, kk);
    {
#pragma unroll
      for (int j = 0; j < 8; ++j) Gf[t * 65 + k0 + j] = lf[j];
      *(LAS u32x4*)(VT + t * 72 + k0) = iraw; }
    (void)iv;
    LBAR();
    cumsum64(Gf, seg);
    { float kd[8];
#pragma unroll
      for (int j = 0; j < 8; ++j) { const float G = Gf[t * 65 + k0 + j], Gl = Gf[63 * 65 + k0 + j]; kd[j] = kk[j] * __builtin_amdgcn_exp2f(Gl - G); }
      if (t == 63) { f32x4 d0, d1;
#pragma unroll
          for (int j = 0; j < 4; ++j) { d0[j] = __builtin_amdgcn_exp2f(Gf[63 * 65 + k0 + j]); d1[j] = __builtin_amdgcn_exp2f(Gf[63 * 65 + k0 + 4 + j]); }
          float* dp = (float*)(p.ws + WS_DECH) + ((size_t)bc * 6 + h) * 64 + k0; *(f32x4*)dp = d0; *(f32x4*)(dp + 4) = d1; }
      *(LAS u32x4*)(KT + t * 72 + k0) = pack8(kd); }
    LBAR();
    { const int wid = tid >> 6, lane = tid & 63, fr = lane & 15, fq = lane >> 4, kt = wid >> 1;
      bf16_t* sth = (bf16_t*)(p.ws + WS_STH) + ((size_t)bc * 6 + h) * 4096;
#pragma unroll
      for (int q = 0; q < 2; ++q) { const int vt = (wid & 1) * 2 + q; f32x4 acc = (f32x4){0.f, 0.f, 0.f, 0.f};
#pragma unroll
          for (int ks = 0; ks < 2; ++ks) { const unsigned ro = (unsigned)((32 * ks + 8 * fq + (fr >> 2)) * 144 + 8 * (fr & 3));
              const unsigned ka = (unsigned)(size_t)KT + ro + 32u * kt, va = (unsigned)(size_t)VT + ro + 32u * vt;
              const bf16x8 a = tr_frag(ka, ka + 576u), b = tr_frag(va, va + 576u); acc = MFMA16(a, b, acc); }
          *(u32x2*)(sth + (size_t)(vt * 16 + fr) * 64 + kt * 16 + fq * 4) = pack4(acc); } }
    LBAR();
}

__device__ __forceinline__ void hgrn_c_unit(LAS unsigned char* lds, KP& P_, int l, int bc, int h, const HgRaw& in) {
    LAS float* Gf = (LAS float*)lds; LAS float* seg = (LAS float*)(lds + 16640);
    LAS bf16_t* QP = (LAS bf16_t*)(lds + 18688); LAS bf16_t* QPP = (LAS bf16_t*)(lds + 27904); LAS bf16_t* KP = (LAS bf16_t*)(lds + 37120);
    LAS bf16_t* VT = (LAS bf16_t*)(lds + 46336); LAS bf16_t* PM = (LAS bf16_t*)(lds + 55552); LAS float* ss = (LAS float*)(lds + 64768);
    const bf16_t* proj = (const bf16_t*)(p.ws + WS_PROJ); const float* lbv = (const float*)(p.ws + TBL(T_LB, l));
    const int tid = tidx(), t = tid >> 3, k0 = (tid & 7) * 8; const size_t row = (size_t)bc * 64 + t;
    const int wid = tid >> 6, lane = tid & 63, fr = lane & 15, fq = lane >> 4;
    float z[8], q[8], lf[8], kk[8], lb[8];
    const int tt2 = wid & 3, vh = wid >> 2;
    bf16x8 sf[2][2]; u32x2 graw[2];
    { const bf16_t* sth = (const bf16_t*)(p.ws + WS_STH) + ((size_t)bc * 6 + h) * 4096;
#pragma unroll
      for (int qq = 0; qq < 2; ++qq) { const int vt = vh * 2 + qq;
#pragma unroll
          for (int ks = 0; ks < 2; ++ks) sf[qq][ks] = *(const bf16x8*)(sth + (size_t)(vt * 16 + fr) * 64 + ks * 32 + fq * 8);
          graw[qq] = *(const u32x2*)(proj + ((size_t)bc * 64 + tt2 * 16 + fr) * NPROJ + C_G + h * 64 + vt * 16 + fq * 4); } }
    f32x4 nwv[2];
#pragma unroll
    for (int qq = 0; qq < 2; ++qq) nwv[qq] = *(const f32x4*)(p.in[4] + l * 64 + (vh * 2 + qq) * 16 + fq * 4);
    unpack8(in.q, q);
    unpack8(in.f, z);
    const u32x4 iraw = in.i;
#pragma unroll
    for (int j = 0; j < 8; ++j) { lb[j] = j < 4 ? in.lb0[j & 3] : in.lb1[j & 3]; q[j] = siluf_(q[j]); }
    hgrn_gates(z, lb, lf, kk);
    {
#pragma unroll
      for (int j = 0; j < 8; ++j) Gf[t * 65 + k0 + j] = lf[j];
      *(LAS u32x4*)(VT + t * 72 + k0) = iraw; }
    LBAR();
    cumsum64(Gf, seg);
    { float a[8], b[8], c[8];
#pragma unroll
      for (int j = 0; j < 8; ++j) { const float G = Gf[t * 65 + k0 + j], R = Gf[31 * 65 + k0 + j]; a[j] = q[j] * __builtin_amdgcn_exp2f(G - R); b[j] = q[j] * __builtin_amdgcn_exp2f(G); c[j] = kk[j] * __builtin_amdgcn_exp2f(R - G); }
      *(LAS u32x4*)(QP + t * 72 + k0) = pack8(a); *(LAS u32x4*)(QPP + t * 72 + k0) = pack8(b); *(LAS u32x4*)(KP + t * 72 + k0) = pack8(c); }
    LBAR();
    {
        const int tt = wid >> 1;
#pragma unroll
        for (int qq = 0; qq < 2; ++qq) { const int st = (wid & 1) * 2 + qq; f32x4 acc = (f32x4){0.f, 0.f, 0.f, 0.f};
            if (st <= tt) {
#pragma unroll
                for (int ks = 0; ks < 2; ++ks) { const bf16x8 a = *(const LAS bf16x8*)(KP + (st * 16 + fr) * 72 + ks * 32 + fq * 8), b = *(const LAS bf16x8*)(QP + (tt * 16 + fr) * 72 + ks * 32 + fq * 8); acc = MFMA16(a, b, acc); }
                const int tq = tt * 16 + fr;
#pragma unroll
                for (int j = 0; j < 4; ++j) if (st * 16 + fq * 4 + j > tq) acc[j] = 0.f;
            }
            *(LAS u32x2*)(PM + (tt * 16 + fr) * 72 + st * 16 + fq * 4) = pack4(acc); }
    }
    LBAR();
    const int tt = tt2;
    f32x4 o[2];
    { float ssq = 0.f;
#pragma unroll
      for (int qq = 0; qq < 2; ++qq) { const int vt = vh * 2 + qq; f32x4 acc = (f32x4){0.f, 0.f, 0.f, 0.f};
#pragma unroll
          for (int ks = 0; ks < 2; ++ks) { const unsigned va = (unsigned)(size_t)VT + (unsigned)((32 * ks + 8 * fq + (fr >> 2)) * 144 + 8 * (fr & 3)) + 32u * vt;
              const bf16x8 a = tr_frag(va, va + 576u), b = *(const LAS bf16x8*)(PM + (tt * 16 + fr) * 72 + ks * 32 + fq * 8); acc = MFMA16(a, b, acc); }
#pragma unroll
          for (int ks = 0; ks < 2; ++ks) { const bf16x8 b = *(const LAS bf16x8*)(QPP + (tt * 16 + fr) * 72 + ks * 32 + fq * 8); acc = MFMA16(sf[qq][ks], b, acc); }
          o[qq] = acc; ssq += (acc[0] * acc[0] + acc[1] * acc[1]) + (acc[2] * acc[2] + acc[3] * acc[3]); }
      ssq += __shfl_xor(ssq, 16); ssq += __shfl_xor(ssq, 32);
      if (fq == 0) ss[(tt * 16 + fr) * 2 + vh] = ssq; }
    LBAR();
    { const int tq = tt * 16 + fr; const float rinv = __builtin_amdgcn_rsqf((ss[tq * 2] + ss[tq * 2 + 1]) * (1.0f / 64.0f) + RMS_EPS);
      const size_t orow = (size_t)bc * 64 + tq; bf16_t* mixed = (bf16_t*)(p.ws + WS_MIXED); const float* nw = p.in[4] + l * 64;
#pragma unroll
      for (int qq = 0; qq < 2; ++qq) { const int v = (vh * 2 + qq) * 16 + fq * 4;
          const float gv[4] = {bflo(graw[qq].x), bfhi(graw[qq].x), bflo(graw[qq].y), bfhi(graw[qq].y)}; f32x4 r;
#pragma unroll
          for (int j = 0; j < 4; ++j) r[j] = o[qq][j] * rinv * nwv[qq][j] * siluf_(gv[j]);
          *(u32x2*)(mixed + orow * DM + h * 64 + v) = pack4(r); } }
    LBAR();
}

__device__ __forceinline__ void m2_dt(KP& P_, int l, int bc, int grp, LAS float* dtl, LAS float* acs, LAS float* wl, bool write_dec) {
    const int tid = tidx(), wid = tid >> 6, lane = tid & 63;
    if (wid < 3) {
        const int head = grp * 3 + wid; const float draw = ((const float*)(p.ws + WS_DT))[((size_t)bc * 64 + lane) * 8 + head];
        const float dt = draw < -1e29f ? 0.f : softplusf_(draw + p.in[7][l * 6 + head]);
        const float a = -expf(p.in[8][l * 6 + head]); float x = dt * a;
#pragma unroll
        for (int off = 1; off < 64; off <<= 1) { const float v = __shfl_up(x, off); if (lane >= off) x += v; }
        const float tot = __shfl(x, 63);
        dtl[wid * 64 + lane] = dt; acs[wid * 64 + lane] = x; wl[wid * 64 + lane] = dt * __expf(tot - x);
        if (write_dec && lane == 63) ((float*)(p.ws + WS_DECM))[(size_t)bc * 6 + head] = __expf(tot);
    }
}
__device__ __forceinline__ void m2_load_cw(LAS float* CW, KP& P_, int l, int grp, int nch) {
    const float* cw = p.in[5] + (size_t)l * 4 * 896; const float* cb = p.in[6] + (size_t)l * 896;
    float v[5]; const int t0 = tidx();
#pragma unroll
    for (int q = 0; q < 5; ++q) { const int i = t0 + q * NTHR; v[q] = 0.f;
        if (i < 5 * nch) { const int tap = i / nch, c = i - tap * nch;
            const int gch = c < 192 ? grp * 192 + c : (c < 320 ? 384 + grp * 128 + (c - 192) : 640 + grp * 128 + (c - 320));
            v[q] = tap < 4 ? cw[tap * 896 + gch] : cb[gch]; } }
#pragma unroll
    for (int q = 0; q < 5; ++q) { const int i = t0 + q * NTHR; if (i < 5 * nch) { const int tap = i / nch, c = i - tap * nch; CW[tap * 448 + c] = v[q]; } }
}
__device__ __forceinline__ int m2_pcol(int grp, int cgi) { return cgi < 24 ? C_X + grp * 192 + cgi * 8 : (cgi < 40 ? C_B + grp * 128 + (cgi - 24) * 8 : C_C + grp * 128 + (cgi - 40) * 8); }
__device__ __forceinline__ void m2_conv_load(KP& P_, int bc, int t, int pcol, u32x4* raw) {
    const bf16_t* proj = (const bf16_t*)(p.ws + WS_PROJ);
#pragma unroll
    for (int tap = 0; tap < 4; ++tap) { const int gr = max(bc * 64 + t - 3 + tap, 0); raw[tap] = *(const u32x4*)(proj + (size_t)gr * NPROJ + pcol); }
}
__device__ __forceinline__ void m2_conv_compute(const LAS float* CW, int c0, const u32x4* raw, float* y) {
    { const f32x4 b0 = *(const LAS f32x4*)(CW + 4 * 448 + c0), b1 = *(const LAS f32x4*)(CW + 4 * 448 + c0 + 4);
#pragma unroll
      for (int j = 0; j < 4; ++j) { y[j] = b0[j]; y[4 + j] = b1[j]; } }
#pragma unroll
    for (int tap = 0; tap < 4; ++tap) { float x[8]; unpack8(raw[tap], x); const f32x4 w0 = *(const LAS f32x4*)(CW + tap * 448 + c0), w1 = *(const LAS f32x4*)(CW + tap * 448 + c0 + 4);
#pragma unroll
        for (int j = 0; j < 4; ++j) { y[j] += w0[j] * x[j]; y[4 + j] += w1[j] * x[4 + j]; } }
#pragma unroll
    for (int j = 0; j < 8; ++j) y[j] = siluf_(y[j]);
}

__device__ void m2_a_unit(LAS unsigned char* lds, KP& P_, int l, int bc, int grp) {
    LAS bf16_t* XN = (LAS bf16_t*)lds;
    LAS bf16_t* BN = (LAS bf16_t*)(lds + 27648);
    LAS float* dtl = (LAS float*)(lds + 46080); LAS float* acs = (LAS float*)(lds + 46848); LAS float* wl = (LAS float*)(lds + 47616); LAS float* CW = (LAS float*)(lds + 48384);
    const int tid = tidx(), wid = tid >> 6, lane = tid & 63, fr = lane & 15, fq = lane >> 4;
    u32x4 raw[5][4];
    { int t = tid / 40, cgi = tid - t * 40;
#pragma unroll
      for (int it = 0; it < 5; ++it) { m2_conv_load(P_, bc, t, m2_pcol(grp, cgi), raw[it]); t += 12; cgi += 32; if (cgi >= 40) { cgi -= 40; ++t; } } }
    m2_dt(P_, l, bc, grp, dtl, acs, wl, true);
    m2_load_cw(CW, P_, l, grp, 320);
    LBAR();
    int t = tid / 40, cgi = tid - (tid / 40) * 40;
#pragma unroll
    for (int it = 0; it < 5; ++it) { float y[8];
        m2_conv_compute(CW, cgi * 8, raw[it], y);
        if (cgi < 24) { const float w = wl[(cgi >> 3) * 64 + t];
#pragma unroll
            for (int j = 0; j < 8; ++j) y[j] *= w;
            *(LAS u32x4*)(XN + t * 200 + cgi * 8) = pack8(y); }
        else *(LAS u32x4*)(BN + t * 136 + (cgi - 24) * 8) = pack8(y);
        t += 12; cgi += 32; if (cgi >= 40) { cgi -= 40; ++t; } }
    LBAR();
    { const int nt = wid; bf16x8 a[2];
      const unsigned xn_base = (unsigned)(size_t)XN, bn_base = (unsigned)(size_t)BN;
#pragma unroll
      for (int ks = 0; ks < 2; ++ks) { const unsigned ba = bn_base + (unsigned)((32 * ks + 8 * fq + (fr >> 2)) * 272 + 8 * (fr & 3)) + 32u * nt; a[ks] = tr_frag(ba, ba + 1088u); }
      bf16_t* stm = (bf16_t*)(p.ws + WS_STM);
      for (int pt = 0; pt < 12; ++pt) { f32x4 acc = (f32x4){0.f, 0.f, 0.f, 0.f};
#pragma unroll
          for (int ks = 0; ks < 2; ++ks) { const unsigned xa = xn_base + (unsigned)((32 * ks + 8 * fq + (fr >> 2)) * 400 + 8 * (fr & 3)) + 32u * pt; const bf16x8 b = tr_frag(xa, xa + 1600u); acc = MFMA16(a[ks], b, acc); }
          const int head = grp * 3 + (pt >> 2), pl = (pt & 3) * 16 + fr;
          *(u32x2*)(stm + (((size_t)bc * 6 + head) * 64 + pl) * 128 + nt * 16 + fq * 4) = pack4(acc); } }
    LBAR();
}

__device__ void m2_c_unit(LAS unsigned char* lds, KP& P_, int l, int bc, int grp) {
    LAS bf16_t* XN = (LAS bf16_t*)lds;
    LAS bf16_t* BM = (LAS bf16_t*)(lds + 27648); LAS bf16_t* CM = (LAS bf16_t*)(lds + 45056); LAS bf16_t* PH = (LAS bf16_t*)(lds + 62464);
    LAS float* dtl = (LAS float*)(lds + 90112); LAS float* acs = (LAS float*)(lds + 90880); LAS float* wl = (LAS float*)(lds + 91648); LAS float* ss = (LAS float*)(lds + 92416);
    LAS float* CW = (LAS float*)(lds + 92928);
    const bf16_t* proj = (const bf16_t*)(p.ws + WS_PROJ);
    const int tid = tidx(), wid = tid >> 6, lane = tid & 63, fr = lane & 15, fq = lane >> 4;
    {
        u32x4 raw[7][4];
        { int t = tid / 56, cgi = tid - t * 56;
#pragma unroll
          for (int it = 0; it < 7; ++it) { m2_conv_load(P_, bc, t, m2_pcol(grp, cgi), raw[it]); t += 9; cgi += 8; if (cgi >= 56) { cgi -= 56; ++t; } } }
        m2_dt(P_, l, bc, grp, dtl, acs, wl, false);
        m2_load_cw(CW, P_, l, grp, 448);
        LBAR();
        int t = tid / 56, cgi = tid - (tid / 56) * 56;
#pragma unroll
        for (int it = 0; it < 7; ++it) { float y[8];
            m2_conv_compute(CW, cgi * 8, raw[it], y);
            if (cgi < 24) *(LAS u32x4*)(XN + t * 200 + cgi * 8) = pack8(y);
            else if (cgi < 40) *(LAS u32x4*)(BM + t * 136 + (cgi - 24) * 8) = pack8(y);
            else *(LAS u32x4*)(CM + t * 136 + (cgi - 40) * 8) = pack8(y);
            t += 9; cgi += 8; if (cgi >= 56) { cgi -= 56; ++t; } }
    }
    LBAR();
    {
        const int tt = wid >> 1;
#pragma unroll
        for (int qq = 0; qq < 2; ++qq) { const int st = (wid & 1) * 2 + qq; f32x4 acc = (f32x4){0.f, 0.f, 0.f, 0.f};
            if (st <= tt) {
#pragma unroll
                for (int ks = 0; ks < 4; ++ks) { const bf16x8 a = *(const LAS bf16x8*)(BM + (st * 16 + fr) * 136 + ks * 32 + fq * 8), b = *(const LAS bf16x8*)(CM + (tt * 16 + fr) * 136 + ks * 32 + fq * 8); acc = MFMA16(a, b, acc); } }
            const int tq = tt * 16 + fr;
#pragma unroll
            for (int hh = 0; hh < 3; ++hh) { f32x4 r; const float at = acs[hh * 64 + tq];
#pragma unroll
                for (int j = 0; j < 4; ++j) { const int s = st * 16 + fq * 4 + j; r[j] = (s <= tq) ? acc[j] * __expf(at - acs[hh * 64 + s]) * dtl[hh * 64 + s] : 0.f; }
                *(LAS u32x2*)(PH + hh * 4608 + tq * 72 + st * 16 + fq * 4) = pack4(r); } }
    }
    LBAR();
    const int tt = wid & 3, ph = wid >> 2, tq = tt * 16 + fr; const size_t orow = (size_t)bc * 64 + tq;
    const unsigned xn_base = (unsigned)(size_t)XN;
    f32x4 yv[6], nwv[6];
#pragma unroll
    for (int i = 0; i < 6; ++i) nwv[i] = *(const f32x4*)(p.in[10] + l * 384 + grp * 192 + (ph * 6 + i) * 16 + fq * 4);
    { bf16x8 cf[4];
#pragma unroll
      for (int ks = 0; ks < 4; ++ks) cf[ks] = *(const LAS bf16x8*)(CM + tq * 136 + ks * 32 + fq * 8);
      const bf16_t* stm = (const bf16_t*)(p.ws + WS_STM); float ssq = 0.f;
      u32x2 zraw[6];
#pragma unroll
      for (int i = 0; i < 6; ++i) zraw[i] = *(const u32x2*)(proj + orow * NPROJ + C_Z + grp * 192 + (ph * 6 + i) * 16 + fq * 4);
      bf16x8 hf[4];
#pragma unroll
      for (int ks = 0; ks < 4; ++ks) hf[ks] = *(const bf16x8*)(stm + (((size_t)bc * 6 + grp * 3 + ((ph * 6) >> 2)) * 64 + ((ph * 6) & 3) * 16 + fr) * 128 + ks * 32 + fq * 8);
#pragma unroll
      for (int i = 0; i < 6; ++i) { const int pt = ph * 6 + i, hh = pt >> 2, head = grp * 3 + hh;
          f32x4 ad = (f32x4){0.f, 0.f, 0.f, 0.f}, ao = (f32x4){0.f, 0.f, 0.f, 0.f};
          bf16x8 hc[4];
#pragma unroll
          for (int ks = 0; ks < 4; ++ks) hc[ks] = hf[ks];
          if (i < 5) { const int pn = pt + 1;
#pragma unroll
              for (int ks = 0; ks < 4; ++ks) hf[ks] = *(const bf16x8*)(stm + (((size_t)bc * 6 + grp * 3 + (pn >> 2)) * 64 + (pn & 3) * 16 + fr) * 128 + ks * 32 + fq * 8); }
#pragma unroll
          for (int ks = 0; ks < 2; ++ks) { const unsigned ta = xn_base + (unsigned)((32 * ks + 8 * fq + (fr >> 2)) * 400 + (16 * pt + 4 * (fr & 3)) * 2);
              const bf16x8 a = tr_frag(ta, ta + 1600u), b = *(const LAS bf16x8*)(PH + hh * 4608 + tq * 72 + ks * 32 + fq * 8); ad = MFMA16(a, b, ad); }
#pragma unroll
          for (int ks = 0; ks < 4; ++ks) ao = MFMA16(hc[ks], cf[ks], ao);
          const float ea = __expf(acs[hh * 64 + tq]), dsk = p.in[9][l * 6 + head]; const int pch = pt * 16 + fq * 4;
          const float zv[4] = {bflo(zraw[i].x), bfhi(zraw[i].x), bflo(zraw[i].y), bfhi(zraw[i].y)};
          f32x4 y;
          const u32x2 xraw = *(const LAS u32x2*)(XN + tq * 200 + pch); const float xsv[4] = {bflo(xraw.x), bfhi(xraw.x), bflo(xraw.y), bfhi(xraw.y)};
#pragma unroll
          for (int j = 0; j < 4; ++j) { y[j] = (ad[j] + ea * ao[j] + dsk * xsv[j]) * siluf_(zv[j]); ssq += y[j] * y[j]; }
          yv[i] = y; }
      ssq += __shfl_xor(ssq, 16); ssq += __shfl_xor(ssq, 32);
      if (fq == 0) ss[tq * 2 + ph] = ssq; }
    LBAR();
    { const float rinv = __builtin_amdgcn_rsqf((ss[tq * 2] + ss[tq * 2 + 1]) * (1.0f / 192.0f) + RMS_EPS);
      bf16_t* mixed = (bf16_t*)(p.ws + WS_MIXED); const float* nw = p.in[10] + l * 384 + grp * 192;
#pragma unroll
      for (int i = 0; i < 6; ++i) { const int pch = (ph * 6 + i) * 16 + fq * 4; f32x4 r;
#pragma unroll
          for (int j = 0; j < 4; ++j) r[j] = yv[i][j] * rinv * nwv[i][j];
          *(u32x2*)(mixed + orow * DM + 384 + grp * 192 + pch) = pack4(r); } }
    LBAR();
}

__device__ __forceinline__ void s5_bu_block(const LAS bf16_t* UB, LAS bf16_t* XW, const bf16x8* bfrag, int blk, int g, int fr, int fq) {
    bf16x8 af = (bf16x8){0, 0, 0, 0, 0, 0, 0, 0};
    if (fq < 2) af = *(const LAS bf16x8*)(UB + (blk * 16 + fr) * 264 + g * 16 + fq * 8);
#pragma unroll
    for (int tile = 0; tile < 8; ++tile) { f32x4 acc = (f32x4){0.f, 0.f, 0.f, 0.f}; acc = MFMA16(bfrag[tile], af, acc);
        *(LAS u32x2*)(XW + fr * 136 + tile * 16 + fq * 4) = pack4(acc); }
    asm volatile("" ::: "memory");
}
__device__ __forceinline__ void s5_load_bfrag(KP& P_, int l, bf16x8* bfrag, int g, int fr, int fq) {
    const bf16_t* bbh = (const bf16_t*)(p.ws + TBL(T_S5BBH, l)) + (size_t)(g * 128 + fr) * 16 + (fq & 1) * 8;
#pragma unroll
    for (int tile = 0; tile < 8; ++tile) { bfrag[tile] = (bf16x8){0, 0, 0, 0, 0, 0, 0, 0}; if (fq < 2) bfrag[tile] = *(const bf16x8*)(bbh + tile * 256); }
}
__device__ __forceinline__ void s5_load_u(LAS bf16_t* UB, KP& P_, int bc) {
    const bf16_t* proj = (const bf16_t*)(p.ws + WS_PROJ);
    for (int it = 0; it < 4; ++it) { const int item = it * NTHR + tidx(), t = item >> 5, c8 = (item & 31) * 8;
        *(LAS u32x4*)(UB + t * 264 + c8) = *(const u32x4*)(proj + ((size_t)bc * 64 + t) * NPROJ + C_U + c8); }
}
__device__ void s5_a_unit(LAS unsigned char* lds, KP& P_, int l, int bc) {
    LAS bf16_t* UB = (LAS bf16_t*)lds; LAS bf16_t* XB = (LAS bf16_t*)(lds + 33792);
    const int tid = tidx(), wid = tid >> 6, lane = tid & 63, fr = lane & 15, fq = lane >> 4;
    s5_load_u(UB, P_, bc);
    LBAR();
    LAS bf16_t* XW = XB + wid * 2176;
    for (int gp = 0; gp < 2; ++gp) { const int g = gp * 8 + wid, n = lane;
        bf16x8 bfrag[8]; s5_load_bfrag(P_, l, bfrag, g, fr, fq);
        const f32x4 lam = *(const f32x4*)((const float*)(p.ws + TBL(T_S5LAM, l)) + (size_t)(g * 64 + n) * 4);
        float xr = 0.f, xi = 0.f;
        for (int blk = 0; blk < 4; ++blk) {
            s5_bu_block(UB, XW, bfrag, blk, g, fr, fq);
#pragma unroll
            for (int tl = 0; tl < 16; ++tl) { const unsigned w = *(const LAS unsigned*)(XW + tl * 136 + 2 * n);
                const float nr = lam[0] * xr - lam[1] * xi + bflo(w), ni = lam[0] * xi + lam[1] * xr + bfhi(w); xr = nr; xi = ni; }
            asm volatile("" ::: "memory");
        }
        *(f32x2*)((float*)(p.ws + WS_STS) + (((size_t)bc * 16 + g) * 64 + n) * 2) = (f32x2){xr, xi}; }
    LBAR();
}
__device__ void s5_c_unit(LAS unsigned char* lds, KP& P_, int l, int bc) {
    LAS bf16_t* UB = (LAS bf16_t*)lds; LAS bf16_t* XB = (LAS bf16_t*)(lds + 33792); LAS bf16_t* YG = (LAS bf16_t*)(lds + 68608);
    const int tid = tidx(), wid = tid >> 6, lane = tid & 63, fr = lane & 15, fq = lane >> 4;
    s5_load_u(UB, P_, bc);
    LBAR();
    LAS bf16_t* XW = XB + wid * 2176;
    for (int gp = 0; gp < 2; ++gp) { const int g = gp * 8 + wid, n = lane;
        bf16x8 bfrag[8]; s5_load_bfrag(P_, l, bfrag, g, fr, fq);
        const f32x4 lam = *(const f32x4*)((const float*)(p.ws + TBL(T_S5LAM, l)) + (size_t)(g * 64 + n) * 4);
        const f32x2 x0 = *(const f32x2*)((const float*)(p.ws + WS_STS) + (((size_t)bc * 16 + g) * 64 + n) * 2);
        float xr = x0.x, xi = x0.y;
        bf16x8 cf[4]; const bf16_t* cm = (const bf16_t*)(p.ws + TBL(T_S5C, l)) + (size_t)(g * 16 + fr) * 128;
#pragma unroll
        for (int ks = 0; ks < 4; ++ks) cf[ks] = *(const bf16x8*)(cm + ks * 32 + fq * 8);
        const float* dsk = p.in[18] + l * 256 + g * 16 + fq * 4;
        for (int blk = 0; blk < 4; ++blk) {
            s5_bu_block(UB, XW, bfrag, blk, g, fr, fq);
#pragma unroll
            for (int tl = 0; tl < 16; ++tl) { LAS unsigned* wp = (LAS unsigned*)(XW + tl * 136 + 2 * n); const unsigned w = *wp;
                const float nr = lam[0] * xr - lam[1] * xi + bflo(w), ni = lam[0] * xi + lam[1] * xr + bfhi(w); xr = nr; xi = ni; *wp = cvt_pk_bf16(xr, xi); }
            asm volatile("" ::: "memory");
            f32x4 acc = (f32x4){0.f, 0.f, 0.f, 0.f};
#pragma unroll
            for (int ks = 0; ks < 4; ++ks) { const bf16x8 b = *(const LAS bf16x8*)(XW + fr * 136 + ks * 32 + fq * 8); acc = MFMA16(cf[ks], b, acc); }
            const int t = blk * 16 + fr; const u32x2 uraw = *(const LAS u32x2*)(UB + t * 264 + g * 16 + fq * 4);
            const float uv[4] = {bflo(uraw.x), bfhi(uraw.x), bflo(uraw.y), bfhi(uraw.y)}; f32x4 y;
#pragma unroll
            for (int j = 0; j < 4; ++j) y[j] = gelu_tanh(acc[j] + dsk[j] * uv[j]);
            *(LAS u32x2*)(YG + t * 264 + g * 16 + fq * 4) = pack4(y);
            asm volatile("" ::: "memory");
        } }
    LBAR();
    {
        const int tt = wid & 3, jh = wid >> 2, tq = tt * 16 + fr; bf16x8 yf[8];
#pragma unroll
        for (int ks = 0; ks < 8; ++ks) yf[ks] = *(const LAS bf16x8*)(YG + tq * 264 + ks * 32 + fq * 8);
        const bf16_t* glut = (const bf16_t*)(p.ws + TBL(T_GLUT, l)); const float* gb = p.in[20] + l * 256; bf16_t* mixed = (bf16_t*)(p.ws + WS_MIXED);
        bf16x8 gn[8]; f32x4 gbv[8];
#pragma unroll
        for (int i = 0; i < 8; ++i) gbv[i] = *(const f32x4*)(gb + (jh * 8 + i) * 16 + fq * 4);
#pragma unroll
        for (int ks = 0; ks < 8; ++ks) gn[ks] = *(const bf16x8*)(glut + (size_t)(jh * 128 + fr) * 256 + ks * 32 + fq * 8);
#pragma unroll
        for (int i = 0; i < 8; ++i) { const int jt = jh * 8 + i; f32x4 acc = (f32x4){0.f, 0.f, 0.f, 0.f};
            bf16x8 gc[8];
#pragma unroll
            for (int ks = 0; ks < 8; ++ks) gc[ks] = gn[ks];
            if (i < 7) {
#pragma unroll
                for (int ks = 0; ks < 8; ++ks) gn[ks] = *(const bf16x8*)(glut + (size_t)((jt + 1) * 16 + fr) * 256 + ks * 32 + fq * 8); }
#pragma unroll
            for (int ks = 0; ks < 8; ++ks) acc = MFMA16(gc[ks], yf[ks], acc);
            const int jc = jt * 16 + fq * 4; const u32x2 yraw = *(const LAS u32x2*)(YG + tq * 264 + jc); const float yv[4] = {bflo(yraw.x), bfhi(yraw.x), bflo(yraw.y), bfhi(yraw.y)}; f32x4 r;
#pragma unroll
            for (int j = 0; j < 4; ++j) r[j] = yv[j] * sigmoidf_(acc[j] + gbv[i][j]);
            *(u32x2*)(mixed + ((size_t)bc * 64 + tq) * DM + 768 + jc) = pack4(r); }
    }
    LBAR();
}

constexpr int NMIXU = 260 + 520 + 1560;
constexpr size_t WS_CTR = WS_BAR + 14336;
template <int WHICH>
__device__ void phase_mix_dyn(LAS unsigned char* lds, KP& P0, int l0) {
    volatile LAS int* tick = (volatile LAS int*)(lds + LDS_BYTES - 32);
    const int tid0 = tidx();
    unsigned* ctr; { KPtr P_ = P0; ctr = (unsigned*)(p.ws + WS_CTR) + (l0 * 2 + WHICH) * 64; }
    int n1 = 0, n2 = 0;
    if (tid0 == 0) { n1 = (int)__hip_atomic_fetch_add(ctr, 1u, __ATOMIC_RELAXED, __HIP_MEMORY_SCOPE_AGENT); n2 = (int)__hip_atomic_fetch_add(ctr, 1u, __ATOMIC_RELAXED, __HIP_MEMORY_SCOPE_AGENT); }
    int u, un;
    for (;;) {
        if (tid0 == 0) { tick[0] = n1; tick[1] = n2; }
        LBAR();
        u = tick[0]; un = tick[1];
        if (u >= 780) break;
        if (tid0 == 0) { n1 = n2; n2 = (int)__hip_atomic_fetch_add(ctr, 1u, __ATOMIC_RELAXED, __HIP_MEMORY_SCOPE_AGENT); }
        KPtr P_ = P0; int l = l0; asm volatile("" : "+s"(P_.q), "+s"(l));
        if (WHICH == 0) { if (u < 520) m2_a_unit(lds, P_, l, u >> 1, u & 1); else s5_a_unit(lds, P_, l, u - 520); }
        else            { if (u < 520) m2_c_unit(lds, P_, l, u >> 1, u & 1); else s5_c_unit(lds, P_, l, u - 520); }
    }
    if (u >= NMIXU) return;
    HgRaw nxt; { KPtr P_ = P0; asm volatile("" : "+s"(P_.q)); nxt = hg_load<WHICH>(P_, l0, u, tid0); }
    for (;;) {
        if (tid0 == 0) { n1 = n2; n2 = (int)__hip_atomic_fetch_add(ctr, 1u, __ATOMIC_RELAXED, __HIP_MEMORY_SCOPE_AGENT); }
        KPtr P_ = P0; int l = l0; asm volatile("" : "+s"(P_.q), "+s"(l));
        const HgRaw cur = nxt;
        if (un < NMIXU) nxt = hg_load<WHICH>(P_, l, un, tid0);
        if (WHICH == 0) hgrn_a_unit(lds, P_, l, (u - 780) / 6, (u - 780) % 6, cur);
        else            hgrn_c_unit(lds, P_, l, (u - 780) / 6, (u - 780) % 6, cur);
        if (un >= NMIXU) break;
        if (tid0 == 0) { tick[0] = n1; tick[1] = n2; }
        LBAR();
        u = tick[0]; un = tick[1];
    }
}
__device__ void phase_mix_b(KP& P_, int l) {
    const int gt = blockIdx.x * NTHR + tidx(), GT = gridDim.x * NTHR;
    for (int e = gt; e < 24576 + 24576 + 4096; e += GT) {
        if (e < 24576) {
            const int n8 = e & 15, pp = (e >> 4) & 63, bh = e >> 10, head = bh % 6, b = bh / 6;
            bf16_t* base = (bf16_t*)(p.ws + WS_STM) + (((size_t)(b * NCHB) * 6 + head) * 64 + pp) * 128 + n8 * 8; const float* dec = (const float*)(p.ws + WS_DECM) + (size_t)(b * NCHB) * 6 + head;
            float s[8];
#pragma unroll
            for (int j = 0; j < 8; ++j) s[j] = 0.f;
#pragma unroll
            for (int cb = 0; cb < NCHB; cb += 22) { u32x4 uu[22]; float d[22];
#pragma unroll
                for (int i = 0; i < 22; ++i) if (cb + i < NCHB) { uu[i] = *(const u32x4*)(base + (size_t)(cb + i) * 6 * 8192); d[i] = dec[(cb + i) * 6]; }
#pragma unroll
                for (int i = 0; i < 22; ++i) if (cb + i < NCHB) { float uf[8]; unpack8(uu[i], uf); *(u32x4*)(base + (size_t)(cb + i) * 6 * 8192) = pack8(s);
#pragma unroll
                    for (int j = 0; j < 8; ++j) s[j] = d[i] * s[j] + uf[j]; } }
        } else if (e < 24576 + 24576) {
            const int e2 = e - 24576, k4 = e2 & 15, v = (e2 >> 4) & 63, bh = e2 >> 10, h = bh % 6, b = bh / 6;
            bf16_t* base = (bf16_t*)(p.ws + WS_STH) + (((size_t)(b * NCHB) * 6 + h) * 64 + v) * 64 + k4 * 4; const float* dec = (const float*)(p.ws + WS_DECH) + ((size_t)(b * NCHB) * 6 + h) * 64 + k4 * 4;
            f32x4 s = (f32x4){0.f, 0.f, 0.f, 0.f}; asm volatile("" : "+v"(s));
#pragma unroll
            for (int cb = 0; cb < NCHB; cb += 17) { u32x2 uu[17]; f32x4 d[17];
#pragma unroll
                for (int i = 0; i < 17; ++i) if (cb + i < NCHB) { uu[i] = *(const u32x2*)(base + (size_t)(cb + i) * 6 * 4096); d[i] = *(const f32x4*)(dec + (size_t)(cb + i) * 384); }
#pragma unroll
                for (int i = 0; i < 17; ++i) if (cb + i < NCHB) { const f32x4 uf = (f32x4){bflo(uu[i].x), bfhi(uu[i].x), bflo(uu[i].y), bfhi(uu[i].y)}; *(u32x2*)(base + (size_t)(cb + i) * 6 * 4096) = pack4(s);
                    s = d[i] * s + uf; } }
        } else {
            const int e2 = e - 24576 - 24576, gn = e2 & 1023, b = e2 >> 10;
            float* base = (float*)(p.ws + WS_STS) + ((size_t)(b * NCHB) * 1024 + gn) * 2; const f32x4 lam = *(const f32x4*)((const float*)(p.ws + TBL(T_S5LAM, l)) + (size_t)gn * 4);
            float xr = 0.f, xi = 0.f; asm volatile("" : "+v"(xr), "+v"(xi));
#pragma unroll
            for (int cb = 0; cb < NCHB; cb += 33) { f32x2 ev[33];
#pragma unroll
                for (int i = 0; i < 33; ++i) if (cb + i < NCHB) ev[i] = *(const f32x2*)(base + (size_t)(cb + i) * 2048);
#pragma unroll
                for (int i = 0; i < 33; ++i) if (cb + i < NCHB) { *(f32x2*)(base + (size_t)(cb + i) * 2048) = (f32x2){xr, xi};
                    const float nr = lam[2] * xr - lam[3] * xi + ev[i].x, ni = lam[2] * xi + lam[3] * xr + ev[i].y; xr = nr; xi = ni; } }
        }
    }
}

__device__ void phase_final(KP& P_) {
    const bf16_t* xb = (const bf16_t*)(p.ws + WS_PRE); const float* stat = (const float*)(p.ws + WS_STAT1);
    const float* g = p.in[26] + 3 * DM; const float* b = p.in[27] + 3 * DM;
    const int wid = tidx() >> 6, lane = tidx() & 63;
    for (int r = blockIdx.x * 8 + wid; r < NBATCH * SEQ; r += gridDim.x * 8) {
        const int bb = r / SEQ, t = r - bb * SEQ; const size_t row = (size_t)bb * LP + 64 + t;
        f32x2 sv = *(const f32x2*)(stat + (row * 16 + (lane & 15)) * 2); float s1 = sv.x, s2 = sv.y;
#pragma unroll
        for (int o = 1; o < 16; o <<= 1) { s1 += __shfl_xor(s1, o); s2 += __shfl_xor(s2, o); }
        const float mu = s1 * (1.0f / 1024.0f), var = fmaxf(s2 * (1.0f / 1024.0f) - mu * mu, 0.f), rstd = __builtin_amdgcn_rsqf(var + LN_EPS);
#pragma unroll
        for (int q = 0; q < 4; ++q) { const int c = q * 256 + lane * 4; const u32x2 w = *(const u32x2*)(xb + row * DM + c); const f32x4 v = (f32x4){bflo(w.x), bfhi(w.x), bflo(w.y), bfhi(w.y)};
            const f32x4 gg = *(const f32x4*)(g + c), bv = *(const f32x4*)(b + c);
            *(f32x4*)(p.out + (size_t)r * DM + c) = (v - mu) * rstd * gg + bv; }
    }
}

#define XB_TMO      128
#define XB_XCNT(j)  (256  + 64 * (j))
#define XB_XSUB(j)  (1280 + 64 * (j))
#define XB_XGEN(j)  (2304 + 64 * (j))
#define XB_TOP      3328
#define XB_TOPGEN   3392
#define XCD_BAR_WORDS 3456
#define XB_SPIN_CAP (1u << 20)
__device__ __forceinline__ unsigned xb_ld(unsigned* q)              { return __hip_atomic_load(q, __ATOMIC_RELAXED, __HIP_MEMORY_SCOPE_AGENT); }
__device__ __forceinline__ unsigned xb_add(unsigned* q, unsigned v) { return __hip_atomic_fetch_add(q, v, __ATOMIC_RELAXED, __HIP_MEMORY_SCOPE_AGENT); }
__device__ __forceinline__ unsigned xb_xcc_id() { return (unsigned)__builtin_amdgcn_s_getreg((3 << 11) | 20) & 0xFu; }
#define XB_SPIN(cond, bar) do { unsigned _sp = 0; while (cond) { __builtin_amdgcn_s_sleep(1); \
    if ((++_sp & 255u) == 0u) { if (xb_ld(&(bar)[XB_TMO])) break; if (_sp > XB_SPIN_CAP) { atomicAdd(&(bar)[XB_TMO], 1u); break; } } } } while (0)
struct XcdBarrier { unsigned* bar; unsigned x; volatile LAS unsigned* st; };
__device__ __forceinline__ XcdBarrier xcd_barrier_post(unsigned* bar, volatile LAS unsigned* st) {
    XcdBarrier b; b.bar = bar; b.x = xb_xcc_id(); b.st = st;
    if (threadIdx.x == 0) (void)xb_add(&bar[XB_XCNT(b.x)], 1u);
    return b;
}
__device__ __forceinline__ void xcd_barrier_complete(unsigned* bar, unsigned x, unsigned& nloc, unsigned& nx) {
    const unsigned G = gridDim.x * gridDim.y * gridDim.z;
    unsigned sum, cnt, mine, sp = 0u;
    for (;;) {
        sum = 0u; cnt = 0u; mine = 0u;
#pragma unroll
        for (unsigned j = 0; j < 16; ++j) { const unsigned c = xb_ld(&bar[XB_XCNT(j)]); sum += c; cnt += (c > 0u) ? 1u : 0u; mine = (j == x) ? c : mine; }
        if (sum == G) break;
        __builtin_amdgcn_s_sleep(1);
        if ((++sp & 255u) == 0u) { if (xb_ld(&bar[XB_TMO])) break; if (sp > XB_SPIN_CAP) { atomicAdd(&bar[XB_TMO], 1u); break; } }
    }
    nloc = mine > 0u ? mine : 1u; nx = cnt > 0u ? cnt : 1u;
}
__device__ __forceinline__ void xcd_barrier(const XcdBarrier& b) {
    asm volatile("s_waitcnt vmcnt(0)" ::: "memory");
    __syncthreads();
    if (threadIdx.x == 0) {
        unsigned* bar = b.bar;
        __builtin_amdgcn_s_waitcnt(0);
        unsigned nloc = b.st[0], nx = b.st[1];
        if (nloc == 0u) { xcd_barrier_complete(bar, b.x, nloc, nx); b.st[0] = nloc; b.st[1] = nx; }
        const unsigned old = xb_add(&bar[XB_XSUB(b.x)], 1u);
        const unsigned gen = old / nloc;
        if (old + 1u == (gen + 1u) * nloc) {
            __builtin_amdgcn_fence(__ATOMIC_RELEASE, "agent");
            asm volatile("s_waitcnt vmcnt(0)" ::: "memory");
            const unsigned og = xb_add(&bar[XB_TOP], 1u);
            const unsigned tg = og / nx;
            if (og + 1u == (tg + 1u) * nx) xb_add(&bar[XB_TOPGEN], 1u);
            else XB_SPIN(xb_ld(&bar[XB_TOPGEN]) == tg, bar);
            __builtin_amdgcn_fence(__ATOMIC_ACQUIRE, "agent");
            xb_add(&bar[XB_XGEN(b.x)], 1u);
            asm volatile("s_waitcnt vmcnt(0)" ::: "memory");
        } else {
            XB_SPIN(xb_ld(&bar[XB_XGEN(b.x)]) == gen, bar);
            __builtin_amdgcn_fence(__ATOMIC_ACQUIRE, "agent");
            asm volatile("s_waitcnt vmcnt(0)" ::: "memory");
        }
    }
    __syncthreads();
}

constexpr int NPHASE = 2 + 7 * DEPTH;
__device__ __forceinline__ void run_phase(LAS unsigned char* lds, KP& P_, int ph) {
    unsigned char* ob = (unsigned char*)p.out; unsigned char* ws = p.ws;
    if (ph == 0) { phase_init(P_); weights_units(lds, P_, -1, 0, (int)blockIdx.x, (int)gridDim.x); for (int lt = 0; lt < DEPTH; ++lt) tables_units(lds, P_, lt, 49 + 7 * lt); return; }
    if (ph == NPHASE - 1) { phase_final(P_); return; }
    int l = (ph - 1) / 7, k = (ph - 1) % 7; asm volatile("" : "+s"(l), "+s"(k));
    bf16_t* xb = (bf16_t*)(ws + WS_PRE);
    float* statA = (float*)(ws + WS_STAT0); float* statB = (float*)(ws + WS_STAT1);
    const bool tail_first = ((blockIdx.x >> 3) & 1) != 0;
    if (k == 0) { EpiInProj E{statB, (const float*)(ws + WS_C1IN), (const float*)(ws + WS_C2IN), (bf16_t*)(ws + WS_PROJ), (float*)(ws + WS_DT), p.in[7] + l * 6, nullptr, l > 0 ? 1 : 0};
        const int hrank = (((int)blockIdx.x >> 4) << 3) | ((int)blockIdx.x & 7), hsize = (int)gridDim.x >> 1;
        zero_tail_stats(statA);
        if (tail_first) weights_units(lds, P_, l, -1, hrank, hsize);
        gemm_phase(lds, xb, (const bf16_t*)(ob + OUT_WIN), 1024, 64, 12, E);
        if (!tail_first) {
            gemm_tail(lds, xb, (const bf16_t*)(ob + OUT_WIN), 1024, NPROJ, E, hrank, hsize);
            dt_units(lds, xb, (const bf16_t*)(ob + OUT_WIN), statB, (const float*)(ws + WS_C1IN), (const float*)(ws + WS_C2IN), (float*)(ws + WS_DT), l > 0 ? 1 : 0, (bf16_t*)(ws + WS_PROJ), hrank, hsize, 2 * hsize); }
        else if (2 * hsize + hrank < NCHT)
            dt_units(lds, xb, (const bf16_t*)(ob + OUT_WIN), statB, (const float*)(ws + WS_C1IN), (const float*)(ws + WS_C2IN), (float*)(ws + WS_DT), l > 0 ? 1 : 0, (bf16_t*)(ws + WS_PROJ), 2 * hsize + hrank, NCHT, NCHT);
    }
    else if (k == 1) { phase_mix_dyn<0>(lds, P_, l); }
    else if (k == 2) { phase_mix_b(P_, l); weights_units(lds, P_, -1, l < DEPTH - 1 ? l + 1 : -1, ((int)blockIdx.x - 104 + (int)gridDim.x) % (int)gridDim.x, (int)gridDim.x);
    }
    else if (k == 3) { phase_mix_dyn<1>(lds, P_, l); }
    else if (k == 4) { EpiResid E{statB, l > 0 ? p.in[26] + (size_t)(l - 1) * DM : nullptr, l > 0 ? p.in[27] + (size_t)(l - 1) * DM : nullptr, xb, statA, l > 0 ? 0 : 1};
        if (tail_first) gemm_tail16(lds, (const bf16_t*)(ws + WS_MIXED), (const bf16_t*)(ob + OUT_WOUT), 1024, E);
        gemm_phase(lds, (const bf16_t*)(ws + WS_MIXED), (const bf16_t*)(ob + OUT_WOUT), 1024, 64, 4, E);
        if (!tail_first) gemm_tail16(lds, (const bf16_t*)(ws + WS_MIXED), (const bf16_t*)(ob + OUT_WOUT), 1024, E); }
    else if (k == 5) { zero_tail_stats(statB);
        EpiMlpIn E{statA, (const float*)(ws + WS_C1MLP), (const float*)(ws + WS_C2MLP), (bf16_t*)(ws + WS_HID), nullptr};
        if (tail_first) gemm_tail(lds, xb, (const bf16_t*)(ob + OUT_W1), 1024, DFF, E, (int)blockIdx.x, (int)gridDim.x);
        gemm_phase(lds, xb, (const bf16_t*)(ob + OUT_W1), 1024, 64, 16, E);
        if (!tail_first) gemm_tail(lds, xb, (const bf16_t*)(ob + OUT_W1), 1024, DFF, E, (int)blockIdx.x, (int)gridDim.x);
    }
    else { EpiResid E{statA, p.in[22] + (size_t)l * DM, p.in[23] + (size_t)l * DM, xb, statB, 0};
        if (tail_first) gemm_tail16(lds, (const bf16_t*)(ws + WS_HID), (const bf16_t*)(ob + OUT_W2), 4096, E);
        gemm_phase(lds, (const bf16_t*)(ws + WS_HID), (const bf16_t*)(ob + OUT_W2), 4096, 64, 4, E);
        if (!tail_first) gemm_tail16(lds, (const bf16_t*)(ws + WS_HID), (const bf16_t*)(ob + OUT_W2), 4096, E); }
}

#undef p
__global__ void __launch_bounds__(NTHR, 2) mega(Params p) {
    extern __shared__ __attribute__((aligned(16))) unsigned char smem[];
    LAS unsigned char* lds = (LAS unsigned char*)smem;
    const int lo = p.ph_lo, hi = p.ph_hi;
    volatile LAS unsigned* st = (volatile LAS unsigned*)(lds + LDS_BYTES - 16);
    XcdBarrier bar; bar.bar = (unsigned*)(p.ws + WS_BAR); bar.x = 0; bar.st = st;
    if (hi - lo > 1) {
        if (threadIdx.x == 0) { st[0] = 0u; st[1] = 0u; }
        __syncthreads();
        bar = xcd_barrier_post((unsigned*)(p.ws + WS_BAR), st);
    }
    if (hi > 100000) cg::this_grid().sync();
    for (int ph = lo; ph < hi; ++ph) {
        KPtr kp; kp.q = (const __attribute__((address_space(4))) Params*)__builtin_amdgcn_kernarg_segment_ptr();
        asm volatile("" : "+s"(kp.q));
        run_phase(lds, kp, ph);
        if (ph + 1 < hi) xcd_barrier(bar);
    }
}

extern "C" void kernel_launch(void* const* d_in, const int* in_sizes, int n_in, void* d_out, int out_size, void* d_ws, size_t ws_size, hipStream_t stream) {
    static int grid = 0;
    if (grid == 0) {
        if (n_in != 28 || ws_size < WS_END || out_size != NBATCH * SEQ * DM) { fprintf(stderr, "kernel_launch: unexpected shapes (n_in %d, ws %zu, out %d)\n", n_in, ws_size, out_size); grid = -1; return; }
        if (hipFuncSetAttribute((const void*)mega, hipFuncAttributeMaxDynamicSharedMemorySize, LDS_BYTES) != hipSuccess) { fprintf(stderr, "kernel_launch: hipFuncSetAttribute failed\n"); grid = -1; return; }
        int dev = 0, cus = 0, per_cu = 0; hipGetDevice(&dev); hipDeviceGetAttribute(&cus, hipDeviceAttributeMultiprocessorCount, dev);
        hipOccupancyMaxActiveBlocksPerMultiprocessor(&per_cu, (const void*)mega, NTHR, LDS_BYTES);
        if (per_cu < 1) { fprintf(stderr, "kernel_launch: occupancy query says %d blocks per CU\n", per_cu); per_cu = 1; }
        grid = cus * 1;
    }
    if (grid < 0) return;
    Params p{};
    for (int i = 0; i < 28; ++i) p.in[i] = (const float*)d_in[i];
    p.out = (float*)d_out; p.ws = (unsigned char*)d_ws;
#if COOP
    if (hipMemsetAsync((char*)d_ws + WS_BAR, 0, 16384, stream) != hipSuccess) { fprintf(stderr, "kernel_launch: memset failed\n"); return; }
    p.ph_lo = 0; p.ph_hi = NPHASE;
    void* args[] = {&p};
    hipError_t e = hipLaunchCooperativeKernel((const void*)mega, dim3(grid), dim3(NTHR), args, LDS_BYTES, stream);
    if (e != hipSuccess) fprintf(stderr, "cooperative launch failed: %s (grid %d)\n", hipGetErrorString(e), grid);
#else
    for (int ph = 0; ph < NPHASE; ++ph) { p.ph_lo = ph; p.ph_hi = ph + 1; hipLaunchKernelGGL(mega, dim3(grid), dim3(NTHR), LDS_BYTES, stream, p); }
#endif
}
```
